# Optimizing an MI355X kernel written in HIP

```python
import math
import jax, jax.numpy as jnp
from jax import lax
import numpy as np

D_MODEL = 1024
BATCH = 16
SEQ = 4096
DEPTH = 2
DEC_BATCH = 32
DEC_SEQ = 16
PAST_LEN = 1024

CHUNK = 64
D_MIX = 2 * D_MODEL
HEAD_DIM = 64
D_A = 3 * D_MIX // 8
H_A = D_A // HEAD_DIM
R_W = 64
R_A = 64
GN_EPS = 64e-5
D_B = 3 * D_MIX // 8
H_B = D_B // HEAD_DIM
N_GROUPS = 2
HPG = H_B // N_GROUPS
D_STATE = 128
CONV_W = 4
CONV_DIM = D_B + 2 * N_GROUPS * D_STATE
D_C = D_MIX - D_A - D_B
H_C = D_C // HEAD_DIM
SB_BLOCK = 128
W_SHIFT = 3 * D_A + R_W + R_A
O1 = W_SHIFT
O2 = O1 + D_A
O3 = O2 + D_B
O4 = O3 + CONV_DIM
O5 = O4 + H_B
O6 = O5 + D_C
O7 = O6 + D_C
O8 = O7 + D_C
N_IN = O8 + D_C
IN_SPLITS = (O1, O2, O3, O4, O5, O6, O7, O8)

kernel_name = 'hybrid_rwkv7_mamba2_stickbreaking_stream_step'


def rms_norm(x, w, eps=1e-6):
    xf = x.astype(jnp.float32)
    y = xf * lax.rsqrt(jnp.mean(xf * xf, axis=-1, keepdims=True) + eps)
    return (y * w.astype(jnp.float32)).astype(x.dtype)


def token_shift(u, prev, mu):
    u_prev = jnp.concatenate([prev.astype(u.dtype), u[:, :-1]], axis=1)
    return u + (u_prev - u) * mu, u[:, -1:]


def rwkv7_branch(ua, gate, S0, shift0, p):
    B, T, _ = ua.shape
    f32 = jnp.float32
    us, new_shift = token_shift(ua, shift0, p['rwkv_mu'])
    r, k, v, w_lo, a_lo = jnp.split(us, [D_A, 2 * D_A, 3 * D_A, 3 * D_A + R_W], axis=-1)
    w_log = -jax.nn.softplus(-(p['rwkv_w0'] + jnp.tanh(w_lo) @ p['rwkv_w2']).astype(f32)) - 0.5
    decay = jnp.exp(-jnp.exp(w_log))
    a = jax.nn.sigmoid((p['rwkv_a0'] + a_lo @ p['rwkv_a2']).astype(f32))
    heads = lambda t: t.astype(f32).reshape(B, T, H_A, HEAD_DIM)
    r, k, v, decay, a = heads(r), heads(k), heads(v), heads(decay), heads(a)
    kk = k * p['rwkv_k_k'].astype(f32).reshape(H_A, HEAD_DIM)
    kk = kk / jnp.maximum(jnp.sqrt(jnp.sum(kk * kk, axis=-1, keepdims=True)), 1e-12)
    k = k * (1.0 + (a - 1.0) * p['rwkv_k_a'].astype(f32).reshape(H_A, HEAD_DIM))

    def step(S, inp):
        r_t, w_t, k_t, v_t, rm_t, ad_t = inp
        sa = jnp.einsum('bhij,bhj->bhi', S, rm_t)
        S = S * w_t[:, :, None, :] + sa[..., None] * ad_t[:, :, None, :] + v_t[..., None] * k_t[:, :, None, :]
        return S, jnp.einsum('bhij,bhj->bhi', S, r_t)

    seq = tuple(t.swapaxes(0, 1) for t in (r, decay, k, v, -kk, kk * a))
    S_T, y = lax.scan(step, S0.astype(f32), seq)
    y = y.swapaxes(0, 1)
    mean = jnp.mean(y, axis=-1, keepdims=True)
    var = jnp.mean(jnp.square(y - mean), axis=-1, keepdims=True)
    y = (y - mean) * lax.rsqrt(var + GN_EPS) * p['rwkv_ln_w'].astype(f32).reshape(H_A, HEAD_DIM) \
        + p['rwkv_ln_b'].astype(f32).reshape(H_A, HEAD_DIM)
    y = y + jnp.sum(r * k * p['rwkv_r_k'].astype(f32), axis=-1, keepdims=True) * v
    out = y.reshape(B, T, D_A) * jax.nn.silu(gate.astype(f32))
    return out.astype(ua.dtype), S_T.astype(S0.dtype), new_shift.astype(shift0.dtype)


def ssd_chunked(x, dt, A, Bm, Cm, S0):
    Bsz, T = x.shape[:2]
    Q = math.gcd(T, CHUNK)
    nC = T // Q
    ch = lambda t: t.reshape(Bsz, nC, Q, *t.shape[2:])
    x, dt, Bm, Cm = ch(x), ch(dt), ch(Bm), ch(Cm)
    xdt = x * dt[..., None]
    a_cs = jnp.cumsum(dt * A, axis=2).transpose(0, 1, 3, 4, 2)
    tril = jnp.tril(jnp.ones((Q, Q), dtype=bool))
    seg = jnp.exp(jnp.where(tril, a_cs[..., :, None] - a_cs[..., None, :], -jnp.inf))
    scores = jnp.einsum('bcqgn,bcsgn->bcgqs', Cm, Bm)[:, :, :, None] * seg
    y_diag = jnp.einsum('bcgmqs,bcsgmp->bcqgmp', scores, xdt)
    decay_to_end = jnp.exp(a_cs[..., -1:] - a_cs)
    chunk_states = jnp.einsum('bcsgn,bcgms,bcsgmp->bcgmpn', Bm, decay_to_end, xdt)
    chunk_decay = jnp.exp(a_cs[..., -1])

    def step(S, inp):
        st, dec = inp
        return S * dec[..., None, None] + st, S

    S_T, S_in = lax.scan(step, S0, (chunk_states.swapaxes(0, 1), chunk_decay.swapaxes(0, 1)))
    S_in = S_in.swapaxes(0, 1)
    y_off = jnp.einsum('bcqgn,bcgmpn,bcgmq->bcqgmp', Cm, S_in, jnp.exp(a_cs))
    return (y_diag + y_off).reshape(Bsz, T, *x.shape[3:]), S_T


def mamba2_branch(z, xbc, dt_raw, S0, conv0, p):
    B, T, _ = xbc.shape
    f32 = jnp.float32
    xpad = jnp.concatenate([conv0.astype(xbc.dtype), xbc], axis=1)
    new_conv = xpad[:, T:]
    cw = p['ssm_conv_w'].astype(f32)
    conv = sum((xpad[:, i:i + T].astype(f32) * cw[i] for i in range(CONV_W)), start=p['ssm_conv_b'].astype(f32))
    xbc = jax.nn.silu(conv)
    xs, Bm, Cm = jnp.split(xbc, [D_B, D_B + N_GROUPS * D_STATE], axis=-1)
    xs = xs.reshape(B, T, N_GROUPS, HPG, HEAD_DIM)
    Bm = Bm.reshape(B, T, N_GROUPS, D_STATE)
    Cm = Cm.reshape(B, T, N_GROUPS, D_STATE)
    dt = jax.nn.softplus(dt_raw.astype(f32) + p['ssm_dt_bias'].astype(f32)).reshape(B, T, N_GROUPS, HPG)
    A = -jnp.exp(p['ssm_A_log'].astype(f32)).reshape(N_GROUPS, HPG)
    S0g = S0.astype(f32).reshape(B, N_GROUPS, HPG, HEAD_DIM, D_STATE)
    y, S_T = ssd_chunked(xs, dt, A, Bm, Cm, S0g)
    y = y + p['ssm_D'].astype(f32).reshape(N_GROUPS, HPG, 1) * xs
    y = y.reshape(B, T, D_B) * jax.nn.silu(z.astype(f32))
    y = rms_norm(y.reshape(B, T, N_GROUPS, D_B // N_GROUPS),
                 p['ssm_norm_w'].reshape(N_GROUPS, D_B // N_GROUPS), 1e-5).reshape(B, T, D_B)
    return y.astype(z.dtype), S_T.reshape(B, H_B, HEAD_DIM, D_STATE).astype(S0.dtype), new_conv.astype(conv0.dtype)


def stick_breaking_block(q, k, v, q_start):
    f32 = jnp.float32
    z = jnp.einsum('bhqd,bhkd->bhqk', q.astype(f32), k.astype(f32)) * (HEAD_DIM ** -0.5)
    q_pos = q_start + jnp.arange(q.shape[2])
    k_pos = jnp.arange(k.shape[2])
    causal = k_pos[None, :] < q_pos[:, None]
    log_keep = jnp.where(causal, jax.nn.log_sigmoid(-z), 0.0)
    log_tail = lax.cumsum(log_keep, axis=3, reverse=True) - log_keep
    att = jnp.where(causal, jnp.exp(jax.nn.log_sigmoid(z) + log_tail), 0.0)
    return jnp.einsum('bhqk,bhkd->bhqd', att, v.astype(f32))


def stick_breaking_branch(q, k, v, gate, k_cache, v_cache, p):
    B, T, _ = q.shape
    heads = lambda t: t.reshape(B, T, H_C, HEAD_DIM).transpose(0, 2, 1, 3)
    q = rms_norm(heads(q), p['sb_q_norm_w'])
    k = rms_norm(heads(k), p['sb_k_norm_w'])
    v = heads(v)
    P = k_cache.shape[2]
    k_all = jnp.concatenate([k_cache.astype(k.dtype), k], axis=2)
    v_all = jnp.concatenate([v_cache.astype(v.dtype), v], axis=2)
    outs = []
    for start in range(0, T, SB_BLOCK):
        end = min(T, start + SB_BLOCK)
        outs.append(stick_breaking_block(q[:, :, start:end], k_all[:, :, :P + end], v_all[:, :, :P + end], P + start))
    o = jnp.concatenate(outs, axis=2).transpose(0, 2, 1, 3).reshape(B, T, D_C)
    o = o * jax.nn.silu(gate.astype(jnp.float32))
    return o.astype(gate.dtype), k, v


def hybrid_layer(x, p, S_rwkv, shift, S_ssm, conv_buf, k_cache, v_cache):
    h = rms_norm(x, p['norm_w'])
    u = h @ p['w_in']
    ua, ga, zb, xbc, dtb, qc, kc, vc, gc = jnp.split(u, IN_SPLITS, axis=-1)
    oa, S_rwkv, shift = rwkv7_branch(ua, ga, S_rwkv, shift, p)
    ob, S_ssm, conv_buf = mamba2_branch(zb, xbc, dtb, S_ssm, conv_buf, p)
    oc, k_new, v_new = stick_breaking_branch(qc, kc, vc, gc, k_cache, v_cache, p)
    y = x + (jnp.concatenate([oa, ob, oc], axis=-1) @ p['w_out']).astype(x.dtype)
    return y, (S_rwkv, shift, S_ssm, conv_buf, k_new, v_new)


def setup_inputs(seed: int = 0) -> dict:
    key = jax.random.key(seed)
    ks = iter(jax.random.split(key, 40))
    f32 = jnp.float32
    nrm = lambda shape, s: s * jax.random.normal(next(ks), shape, f32)
    uni = lambda shape, lo, hi: jax.random.uniform(next(ks), shape, f32, minval=lo, maxval=hi)
    x_prompt = nrm((BATCH, SEQ, D_MODEL), 1.0)
    x_sample = nrm((DEC_BATCH, DEC_SEQ, D_MODEL), 1.0)
    state_rwkv = nrm((DEPTH, DEC_BATCH, H_A, HEAD_DIM, HEAD_DIM), 0.5)
    state_rwkv_shift = nrm((DEPTH, DEC_BATCH, 1, W_SHIFT), 1.0)
    state_ssm = nrm((DEPTH, DEC_BATCH, H_B, HEAD_DIM, D_STATE), 0.1)
    state_conv = nrm((DEPTH, DEC_BATCH, CONV_W - 1, CONV_DIM), 1.0)
    cache_sb_k = nrm((DEPTH, DEC_BATCH, H_C, PAST_LEN, HEAD_DIM), 1.0)
    cache_sb_v = nrm((DEPTH, DEC_BATCH, H_C, PAST_LEN, HEAD_DIM), 1.0)
    norm_w = 1.0 + nrm((DEPTH, D_MODEL), 0.02)
    w_in = nrm((DEPTH, D_MODEL, N_IN), D_MODEL ** -0.5)
    w_out = nrm((DEPTH, D_MIX, D_MODEL), 0.5 * D_MIX ** -0.5)
    rwkv_mu = uni((DEPTH, W_SHIFT), 0.0, 1.0)
    rwkv_w0 = uni((DEPTH, D_A), -4.0, 1.0)
    rwkv_w2 = nrm((DEPTH, R_W, D_A), 0.5 * R_W ** -0.5)
    rwkv_a0 = nrm((DEPTH, D_A), 0.5)
    rwkv_a2 = nrm((DEPTH, R_A, D_A), 0.5 * R_A ** -0.5)
    rwkv_k_k = 0.85 + nrm((DEPTH, D_A), 0.02)
    rwkv_k_a = 1.0 + nrm((DEPTH, D_A), 0.02)
    rwkv_r_k = nrm((DEPTH, H_A, HEAD_DIM), 0.1)
    rwkv_ln_w = 1.0 + nrm((DEPTH, D_A), 0.02)
    rwkv_ln_b = nrm((DEPTH, D_A), 0.02)
    ssm_conv_w = nrm((DEPTH, CONV_W, CONV_DIM), CONV_W ** -0.5)
    ssm_conv_b = nrm((DEPTH, CONV_DIM), 0.02)
    dt0 = jnp.exp(uni((DEPTH, H_B), math.log(1e-3), math.log(1e-1)))
    ssm_dt_bias = dt0 + jnp.log(-jnp.expm1(-dt0))
    ssm_A_log = jnp.log(uni((DEPTH, H_B), 1.0, 16.0))
    ssm_D = 1.0 + nrm((DEPTH, H_B), 0.1)
    ssm_norm_w = 1.0 + nrm((DEPTH, D_B), 0.02)
    sb_q_norm_w = 1.0 + nrm((DEPTH, HEAD_DIM), 0.02)
    sb_k_norm_w = 1.0 + nrm((DEPTH, HEAD_DIM), 0.02)
    return {'x_prompt': x_prompt, 'x_sample': x_sample,
            'state_rwkv': state_rwkv, 'state_rwkv_shift': state_rwkv_shift,
            'state_ssm': state_ssm, 'state_conv': state_conv,
            'cache_sb_k': cache_sb_k, 'cache_sb_v': cache_sb_v,
            'norm_w': norm_w, 'w_in': w_in, 'w_out': w_out,
            'rwkv_mu': rwkv_mu, 'rwkv_w0': rwkv_w0, 'rwkv_w2': rwkv_w2, 'rwkv_a0': rwkv_a0, 'rwkv_a2': rwkv_a2,
            'rwkv_k_k': rwkv_k_k, 'rwkv_k_a': rwkv_k_a, 'rwkv_r_k': rwkv_r_k,
            'rwkv_ln_w': rwkv_ln_w, 'rwkv_ln_b': rwkv_ln_b,
            'ssm_conv_w': ssm_conv_w, 'ssm_conv_b': ssm_conv_b, 'ssm_dt_bias': ssm_dt_bias,
            'ssm_A_log': ssm_A_log, 'ssm_D': ssm_D, 'ssm_norm_w': ssm_norm_w,
            'sb_q_norm_w': sb_q_norm_w, 'sb_k_norm_w': sb_k_norm_w}


def reference(x_prompt, x_sample, state_rwkv, state_rwkv_shift, state_ssm, state_conv, cache_sb_k, cache_sb_v,
              norm_w, w_in, w_out, rwkv_mu, rwkv_w0, rwkv_w2, rwkv_a0, rwkv_a2, rwkv_k_k, rwkv_k_a, rwkv_r_k,
              rwkv_ln_w, rwkv_ln_b, ssm_conv_w, ssm_conv_b, ssm_dt_bias, ssm_A_log, ssm_D, ssm_norm_w,
              sb_q_norm_w, sb_k_norm_w):
    bp, dtp = x_prompt.shape[0], x_prompt.dtype
    zero_rwkv = jnp.zeros((bp, H_A, HEAD_DIM, HEAD_DIM), dtp)
    zero_shift = jnp.zeros((bp, 1, W_SHIFT), dtp)
    zero_ssm = jnp.zeros((bp, H_B, HEAD_DIM, D_STATE), dtp)
    zero_conv = jnp.zeros((bp, CONV_W - 1, CONV_DIM), dtp)
    empty_kv = jnp.zeros((bp, H_C, 0, HEAD_DIM), dtp)

    yp, ys = x_prompt, x_sample
    new_p = [[] for _ in range(6)]
    new_s = [[] for _ in range(6)]
    for l in range(DEPTH):
        p = {'norm_w': norm_w[l], 'w_in': w_in[l], 'w_out': w_out[l],
             'rwkv_mu': rwkv_mu[l], 'rwkv_w0': rwkv_w0[l], 'rwkv_w2': rwkv_w2[l], 'rwkv_a0': rwkv_a0[l],
             'rwkv_a2': rwkv_a2[l], 'rwkv_k_k': rwkv_k_k[l], 'rwkv_k_a': rwkv_k_a[l], 'rwkv_r_k': rwkv_r_k[l],
             'rwkv_ln_w': rwkv_ln_w[l], 'rwkv_ln_b': rwkv_ln_b[l],
             'ssm_conv_w': ssm_conv_w[l], 'ssm_conv_b': ssm_conv_b[l], 'ssm_dt_bias': ssm_dt_bias[l],
             'ssm_A_log': ssm_A_log[l], 'ssm_D': ssm_D[l], 'ssm_norm_w': ssm_norm_w[l],
             'sb_q_norm_w': sb_q_norm_w[l], 'sb_k_norm_w': sb_k_norm_w[l]}
        yp, st_p = hybrid_layer(yp, p, zero_rwkv, zero_shift, zero_ssm, zero_conv, empty_kv, empty_kv)
        ys, st_s = hybrid_layer(ys, p, state_rwkv[l], state_rwkv_shift[l], state_ssm[l], state_conv[l],
                                cache_sb_k[l], cache_sb_v[l])
        for i in range(6):
            new_p[i].append(st_p[i])
            new_s[i].append(st_s[i])
    p_rwkv, p_shift, p_ssm, p_conv, p_k, p_v = [jnp.stack(t) for t in new_p]
    s_rwkv, s_shift, s_ssm, s_conv, s_k, s_v = [jnp.stack(t) for t in new_s]
    return (yp, ys, p_rwkv, p_shift, p_ssm, p_conv, p_k, p_v, s_rwkv, s_shift, s_ssm, s_conv, s_k, s_v)
```

```cpp
#include <hip/hip_runtime.h>
#include <hip/hip_cooperative_groups.h>
#include <cstdio>
namespace cg = cooperative_groups;

typedef unsigned short u16;
typedef __attribute__((ext_vector_type(8))) short bf16x8;
typedef __attribute__((ext_vector_type(4))) float f32x4;
typedef __attribute__((ext_vector_type(4))) unsigned u32x4;
typedef __attribute__((ext_vector_type(2))) unsigned u32x2;
#define DI __device__ __forceinline__

constexpr int DM = 1024, NB = 16, SEQ = 4096, NSB = 32, SSEQ = 16, PAST = 1024;
constexpr int MP = NB * SEQ, MS = NSB * SSEQ, MT = MP + MS;
constexpr int DA = 768, HA = 12, DB = 768, HB = 12, HPG = 6, DS = 128, CD = 1280, DC = 512, HC = 8;
constexpr int WSH = 2432;
constexpr int O1 = 2432, O2 = 3200, O3 = 3968, O4 = 5248, O5 = 5260, O6 = 5772, O7 = 6284, O8 = 6796, NIN = 7308;
constexpr int NP = 7424, NU = 6400;
constexpr int cGA = 0, cZB = 768, cGC = 1536, cUA = 2048, cXBC = 4480, cQ = 5760, cDT = 6272, cK = 6400, cV = 6912;
constexpr long oYP = 0;
constexpr long oYS = oYP + (long)MP * DM;
constexpr long oPRW = oYS + (long)MS * DM;
constexpr long oPSH = oPRW + 2L * NB * HA * 64 * 64;
constexpr long oPSS = oPSH + 2L * NB * WSH;
constexpr long oPCV = oPSS + 2L * NB * HB * 64 * DS;
constexpr long oPK = oPCV + 2L * NB * 3 * CD;
constexpr long oPV = oPK + 2L * NB * HC * SEQ * 64;
constexpr long oSRW = oPV + 2L * NB * HC * SEQ * 64;
constexpr long oSSH = oSRW + 2L * NSB * HA * 64 * 64;
constexpr long oSSS = oSSH + 2L * NSB * WSH;
constexpr long oSCV = oSSS + 2L * NSB * HB * 64 * DS;
constexpr long oSK = oSCV + 2L * NSB * 3 * CD;
constexpr long oSV = oSK + 2L * NSB * HC * SSEQ * 64;
constexpr size_t wsWIN = 0;
constexpr size_t wsWOUT = wsWIN + 2ull * NP * 1024 * 2;
constexpr size_t wsXN = wsWOUT + 2ull * 1024 * 2048 * 2;
constexpr size_t wsU = wsXN + (size_t)MT * 1024 * 2;
constexpr size_t wsSSQ = wsU + (size_t)MT * NU * 2;
constexpr size_t wsCNT = wsSSQ + (size_t)MT * 2 * 4;
constexpr size_t wsEND = wsCNT + 256;

constexpr int PW_N = 19;
__device__ __constant__ int pw_idx[PW_N] = {8,11,12,13,14,15,16,17,18,19,20,21,22,23,24,25,26,27,28};
__device__ __constant__ int pw_size[PW_N] = {2048,4864,1536,98304,1536,98304,1536,1536,1536,1536,1536,10240,2560,24,24,24,1536,128,128};
__device__ __constant__ int pw_off[PW_N] = {0,2048,6912,8448,106752,108288,206592,208128,209664,211200,212736,214272,224512,227072,227136,227200,227264,228800,228928};
constexpr size_t wsPW = wsEND;
constexpr size_t wsEND2 = wsPW + 229056ull * 4;
#define PW(p, k) ((const float*)((p).ws + wsPW) + PWOFF_##k)
#define PWOFF_8 0
#define PWOFF_11 2048
#define PWOFF_12 6912
#define PWOFF_13 8448
#define PWOFF_14 106752
#define PWOFF_15 108288
#define PWOFF_16 206592
#define PWOFF_17 208128
#define PWOFF_18 209664
#define PWOFF_19 211200
#define PWOFF_20 212736
#define PWOFF_21 214272
#define PWOFF_22 224512
#define PWOFF_23 227072
#define PWOFF_24 227136
#define PWOFF_25 227200
#define PWOFF_26 227264
#define PWOFF_27 228800
#define PWOFF_28 228928

struct Params {
  const float* in[29];
  float* out;
  char* ws;
};

typedef __attribute__((ext_vector_type(2))) float f32x2_t;
typedef __attribute__((ext_vector_type(2))) __bf16 bf16x2_t;
DI u16 f2bf(float x) { return __builtin_bit_cast(u16, (__bf16)x); }
DI float bf2f(u16 v) { return __uint_as_float(((unsigned)v) << 16); }
DI unsigned pack2(float a, float b) { f32x2_t v = {a, b}; return __builtin_bit_cast(unsigned, __builtin_convertvector(v, bf16x2_t)); }
template <int CTRL> DI float dppf(float x) { return __int_as_float(__builtin_amdgcn_update_dpp(0, __float_as_int(x), CTRL, 0xF, 0xF, true)); }
template <int PAT> DI float swzf(float x) { return __int_as_float(__builtin_amdgcn_ds_swizzle(__float_as_int(x), PAT)); }
DI float bperm(float x, int srclane) { return __int_as_float(__builtin_amdgcn_ds_bpermute(srclane << 2, __float_as_int(x))); }
DI float sx1(float x) { return dppf<0xB1>(x); }
DI float sx2(float x) { return dppf<0x4E>(x); }
DI float sx4(float x) { return swzf<0x101F>(x); }
DI float sx8(float x) { return swzf<0x201F>(x); }
DI float sx16(float x) { return swzf<0x401F>(x); }
DI float red16(float v) { v += dppf<0x128>(v); v += dppf<0x124>(v); v += dppf<0x122>(v); v += dppf<0x121>(v); return v; }
DI float wave_sum(float v, int lane) {
  v = red16(v); v += sx16(v); v += bperm(v, lane ^ 32);
  return v;
}
DI float frcp(float x) { return __builtin_amdgcn_rcpf(x); }
DI float silu(float x) { return x * frcp(1.f + __expf(-x)); }
DI float softplusf(float x) { return fmaxf(x, 0.f) + __logf(1.f + __expf(-fabsf(x))); }
DI float dpp_xor1(float x) { return __int_as_float(__builtin_amdgcn_update_dpp(0, __float_as_int(x), 0xB1, 0xF, 0xF, true)); }
DI float dpp_xor2(float x) { return __int_as_float(__builtin_amdgcn_update_dpp(0, __float_as_int(x), 0x4E, 0xF, 0xF, true)); }
DI bf16x8 ldfrag(const u16* base, int ld, int row, int k) {
  return *(const bf16x8*)(base + row * ld + k);
}
DI unsigned uidx(long row, int col) { return ((unsigned)(col >> 6) * (unsigned)MT + (unsigned)row) * 64u + (unsigned)(col & 63); }
DI Params launder_params(const Params& p) {
  Params q = p;
  asm volatile("" : "+s"(q.ws), "+s"(q.out), "+s"(q.in[2]), "+s"(q.in[3]), "+s"(q.in[4]), "+s"(q.in[5]), "+s"(q.in[6]), "+s"(q.in[7]));
  return q;
}
DI int opaque_tid(int wv) { int t = wv * 64 + (int)__builtin_amdgcn_mbcnt_hi(~0u, __builtin_amdgcn_mbcnt_lo(~0u, 0u)); asm volatile("" : "+v"(t)); return t; }
#define MFMA16(a, b, c) __builtin_amdgcn_mfma_f32_16x16x32_bf16((a), (b), (c), 0, 0, 0)

DI const float* xrow(const Params& p, int layer, long row) {
  if (layer == 0) return row < MP ? p.in[0] + row * DM : p.in[1] + (row - MP) * DM;
  return p.out + row * DM;
}
DI int src_col(int n) {
  if (n < 768) return O1 + n;
  if (n < 1536) return O2 + (n - 768);
  if (n < 2048) return O8 + (n - 1536);
  if (n < 4480) return n - 2048;
  if (n < 5760) return O3 + (n - 4480);
  if (n < 6272) return O5 + (n - 5760);
  if (n < 6284) return O4 + (n - 6272);
  if (n < 6400) return -1;
  if (n < 6912) return O6 + (n - 6400);
  return O7 + (n - 6912);
}

DI void phase_wprep(int wv, const Params& p, char* smc) {
  const int otid = opaque_tid(wv);
  for (int a = 0; a < PW_N; ++a) {
    const float* src = p.in[pw_idx[a]];
    float* dst = (float*)(p.ws + wsPW) + pw_off[a];
    for (int i = blockIdx.x * 256 + otid; i < pw_size[a]; i += gridDim.x * 256) dst[i] = src[i];
  }
  float* T = (float*)smc;
  const int tid = otid;
  const int nWin = (NP / 64) * 16, nWout = 32 * 16;
  const int total = 2 * (nWin + nWout);
  for (int t = blockIdx.x; t < total; t += gridDim.x) {
    int layer = t / (nWin + nWout), r = t % (nWin + nWout);
    __syncthreads();
    if (r < nWin) {
      int n0 = (r / 16) * 64, k0 = (r % 16) * 64;
      const float* W = p.in[9] + (size_t)layer * DM * NIN;
      const float* nw = p.in[8] + layer * DM;
      int nn = tid & 63, sc = src_col(n0 + nn);
      for (int kk = tid >> 6; kk < 64; kk += 4)
        T[kk * 65 + nn] = sc >= 0 ? W[(size_t)(k0 + kk) * NIN + sc] * nw[k0 + kk] : 0.f;
      __syncthreads();
      u16* D = (u16*)(p.ws + wsWIN) + (size_t)layer * NP * 1024;
      int kk = tid & 63;
      for (int n2 = tid >> 6; n2 < 64; n2 += 4) D[(size_t)(n0 + n2) * 1024 + k0 + kk] = f2bf(T[kk * 65 + n2]);
    } else {
      r -= nWin;
      int k0 = (r / 16) * 64, n0 = (r % 16) * 64;
      const float* W = p.in[10] + (size_t)layer * 2048 * 1024;
      const float* snw = p.in[26] + layer * DB;
      int nn = tid & 63;
      for (int kk = tid >> 6; kk < 64; kk += 4) {
        int k = k0 + kk;
        float s = (k >= 768 && k < 1536) ? snw[k - 768] : 1.f;
        T[kk * 65 + nn] = W[(size_t)k * 1024 + n0 + nn] * s;
      }
      __syncthreads();
      u16* D = (u16*)(p.ws + wsWOUT) + (size_t)layer * 1024 * 2048;
      int kk = tid & 63;
      for (int n2 = tid >> 6; n2 < 64; n2 += 4) D[(size_t)(n0 + n2) * 2048 + k0 + kk] = f2bf(T[kk * 65 + n2]);
    }
  }
}

DI void phase_norm(int wv, const Params& p, int layer) {
  const int otid = opaque_tid(wv);
  const int wave = otid >> 6, lane = otid & 63;
  u16* XN = (u16*)(p.ws + wsXN);
  for (long row = blockIdx.x * 4 + wave; row < MT; row += gridDim.x * 4) {
    const float4* x = (const float4*)xrow(p, layer, row);
    float4 v[4];
    float ss = 0.f;
#pragma unroll
    for (int i = 0; i < 4; ++i) {
      { const f32x4 t4 = __builtin_nontemporal_load((const f32x4*)x + lane + 64 * i); v[i] = float4{t4[0], t4[1], t4[2], t4[3]}; }
      ss += v[i].x * v[i].x + v[i].y * v[i].y + v[i].z * v[i].z + v[i].w * v[i].w;
    }
    ss = wave_sum(ss, lane);
    float rs = rsqrtf(ss * (1.f / 1024.f) + 1e-6f);
    u32x2* o = (u32x2*)(XN + row * 1024);
#pragma unroll
    for (int i = 0; i < 4; ++i) {
      u32x2 w;
      w[0] = pack2(v[i].x * rs, v[i].y * rs);
      w[1] = pack2(v[i].z * rs, v[i].w * rs);
      o[lane + 64 * i] = w;
    }
  }
  float* ssq = (float*)(p.ws + wsSSQ);
  for (long i = (long)blockIdx.x * 256 + otid; i < (long)MT * 2; i += (long)gridDim.x * 256) ssq[i] = 0.f;
  if (blockIdx.x == 0 && otid == 0) { ((int*)(p.ws + wsCNT))[layer] = 0; ((int*)(p.ws + wsCNT))[layer + 2] = 0; }
}

DI int swz(int row, int c) { return row * 128 + ((c ^ ((row >> 1) & 7)) << 4); }

DI void gemm_mainloop(int wv, const u16* __restrict__ A, long lda, long a_kstep, const u16* __restrict__ Bt, long ldb, int K,
                      char* smc, f32x4 (&acc)[4][4], const bool seg = false, const float* sc0 = nullptr, const float* sc1 = nullptr) {
  const int otid = opaque_tid(wv);
  const int tid = otid, lane = tid & 63, wave = tid >> 6, wm = wave >> 1, wn = wave & 1;
  char* As = smc;
  char* Bs = smc + 32768;
#pragma unroll
  for (int i = 0; i < 4; ++i)
#pragma unroll
    for (int j = 0; j < 4; ++j) acc[i][j] = f32x4{0.f, 0.f, 0.f, 0.f};
  u32x4 ra[4], rb[4], ra2[4], rb2[4];
  const int lr = tid >> 3, lc = tid & 7;
  const u16* ag = A + (long)lr * lda + lc * 8;
  const u16* bg = Bt + (long)lr * ldb + lc * 8;
  const int nk = K / 64;
#pragma unroll
  for (int i = 0; i < 4; ++i) {
    ra[i] = *(const u32x4*)(ag + (long)(32 * i) * lda);
    rb[i] = *(const u32x4*)(bg + (long)(32 * i) * ldb);
  }
#pragma unroll
  for (int i = 0; i < 4; ++i) {
    ra2[i] = *(const u32x4*)(ag + (long)(32 * i) * lda + a_kstep);
    rb2[i] = *(const u32x4*)(bg + (long)(32 * i) * ldb + 64);
  }
  __syncthreads();
#pragma unroll
  for (int i = 0; i < 4; ++i) {
    *(u32x4*)(As + swz(lr + 32 * i, lc)) = ra[i];
    *(u32x4*)(Bs + swz(lr + 32 * i, lc)) = rb[i];
  }
  __syncthreads();
  const int fr = lane & 15, fq = lane >> 4;
#define GEMM_STEP(kt, cur, fa, fb, wa, wb)                                                                       \
  {                                                                                                              \
    {     \
      const int kf = min((kt) + 2, nk - 1);                                                                      \
      _Pragma("unroll") for (int i = 0; i < 4; ++i) {                                                            \
        fa[i] = *(const u32x4*)(ag + (long)(32 * i) * lda + (long)kf * a_kstep);                                 \
        fb[i] = *(const u32x4*)(bg + (long)(32 * i) * ldb + kf * 64);                                            \
      }                                                                                                          \
    }                                                                                                            \
    const char* as = As + (cur) * 16384;                                                                         \
    const char* bs = Bs + (cur) * 16384;                                                                         \
    _Pragma("unroll") for (int ks = 0; ks < 2; ++ks) {                                                           \
      bf16x8 af[4], bfr[4];                                                                                      \
      _Pragma("unroll") for (int i = 0; i < 4; ++i) {                                                            \
        af[i] = *(const bf16x8*)(as + swz(wm * 64 + i * 16 + fr, ks * 4 + fq));                                  \
        bfr[i] = *(const bf16x8*)(bs + swz(wn * 64 + i * 16 + fr, ks * 4 + fq));                                 \
      }                                                                                                          \
      _Pragma("unroll") for (int i = 0; i < 4; ++i)                                                              \
        _Pragma("unroll") for (int j = 0; j < 4; ++j) acc[i][j] = MFMA16(bfr[j], af[i], acc[i][j]);              \
    }                                                                                                            \
    if ((kt) + 1 < nk) {                                                                                         \
      char* an = As + ((cur) ^ 1) * 16384;                                                                       \
      char* bn = Bs + ((cur) ^ 1) * 16384;                                                                       \
      _Pragma("unroll") for (int i = 0; i < 4; ++i) {                                                            \
        *(u32x4*)(an + swz(lr + 32 * i, lc)) = wa[i];                                                            \
        *(u32x4*)(bn + swz(lr + 32 * i, lc)) = wb[i];                                                            \
      }                                                                                                          \
    }                                                                                                            \
    __syncthreads();                                                                                             \
  }
  for (int kt = 0; kt < nk; kt += 2) {
    if (seg && (kt == 12 || kt == 18 || kt == 24)) {
#pragma unroll
      for (int i = 0; i < 4; ++i) {
        const float f = kt == 12 ? 1.f / sc0[i] : (kt == 18 ? sc0[i] / sc1[i] : sc1[i]);
#pragma unroll
        for (int j = 0; j < 4; ++j)
#pragma unroll
          for (int e = 0; e < 4; ++e) acc[i][j][e] *= f;
      }
    }
    GEMM_STEP(kt, 0, ra, rb, ra2, rb2)
    GEMM_STEP(kt + 1, 1, ra2, rb2, ra, rb)
  }
#undef GEMM_STEP
}

DI void phase_inproj(int wv, const Params& p, int layer, char* smc) {
  const int otid = opaque_tid(wv);
  const u16* XN = (const u16*)(p.ws + wsXN);
  const u16* W = (const u16*)(p.ws + wsWIN) + (size_t)layer * NP * 1024;
  u16* U = (u16*)(p.ws + wsU);
  const int lane = otid & 63, wave = otid >> 6, wm = wave >> 1, wn = wave & 1;
  const int fr = lane & 15, fq = lane >> 4;
  const int NTN = NP / 128, NTM = MT / 128;
  const int xcd = blockIdx.x & 7, slot = blockIdx.x >> 3, nslots = gridDim.x >> 3;
  constexpr int PER_XCD = (NTN * NTM) / 8;
  constexpr int FULLG = 7 * 8 * NTM;
  for (int tq = slot; tq < PER_XCD; tq += nslots) {
    const int q = xcd * PER_XCD + tq;
    int tn, tm;
    if (q < FULLG) { const int g8 = q / (8 * NTM), r = q % (8 * NTM); tm = r >> 3; tn = 8 * g8 + (r & 7); }
    else { const int r = q - FULLG; tm = r >> 1; tn = 56 + (r & 1); }
    f32x4 acc[4][4];
    gemm_mainloop(wv, XN + (size_t)tm * 128 * 1024, 1024, 64, W + (size_t)tn * 128 * 1024, 1024, 1024, smc, acc);
    const int colbase = tn * 128 + wn * 64;
    const bool isq = colbase >= cQ && colbase < cDT;
    const bool isk = colbase >= cK && colbase < cV;
    if (isq || isk) {
      const float* nw = isq ? PW(p, 27) + layer * 64 : PW(p, 28) + layer * 64;
      const float sc = isq ? 0.125f : 1.f;
      float nwr[4][4];
#pragma unroll
      for (int n = 0; n < 4; ++n)
#pragma unroll
        for (int jj = 0; jj < 4; ++jj) nwr[n][jj] = nw[n * 16 + 4 * fq + jj] * sc;
#pragma unroll
      for (int i = 0; i < 4; ++i) {
        float ss = 0.f;
#pragma unroll
        for (int n = 0; n < 4; ++n)
#pragma unroll
          for (int jj = 0; jj < 4; ++jj) ss += acc[i][n][jj] * acc[i][n][jj];
        ss += sx16(ss);
        ss += bperm(ss, lane ^ 32);
        const float rs = rsqrtf(ss * (1.f / 64.f) + 1e-6f);
#pragma unroll
        for (int n = 0; n < 4; ++n)
#pragma unroll
          for (int jj = 0; jj < 4; ++jj) acc[i][n][jj] *= rs * nwr[n][jj];
      }
    }
    if (colbase < NU) {
      u16* blk = U + (size_t)(colbase >> 6) * MT * 64 + ((size_t)tm * 128 + wm * 64) * 64;
      u16* R = (u16*)smc + wave * (64 * 72);
#pragma unroll
      for (int i = 0; i < 4; ++i)
#pragma unroll
        for (int n = 0; n < 4; ++n) {
          u32x2 pk;
          pk[0] = pack2(acc[i][n][0], acc[i][n][1]);
          pk[1] = pack2(acc[i][n][2], acc[i][n][3]);
          *(u32x2*)(R + (i * 16 + fr) * 72 + n * 16 + 4 * fq) = pk;
        }
#pragma unroll
      for (int k = 0; k < 8; ++k) {
        const int id = lane + 64 * k, r = id >> 3, c = id & 7;
        __builtin_nontemporal_store(*(const u32x4*)(R + r * 72 + c * 8), (u32x4*)(blk + r * 64 + c * 8));
      }
    } else {
      const bool kk = colbase < cV;
      const int head = (colbase - (kk ? cK : cV)) >> 6;
#pragma unroll
      for (int i = 0; i < 4; ++i) {
        const long row = (long)tm * 128 + wm * 64 + i * 16 + fr;
        float* dst;
        if (row < MP) {
          long b = row >> 12, tt = row & 4095;
          dst = p.out + (kk ? oPK : oPV) + ((((long)layer * NB + b) * HC + head) * SEQ + tt) * 64;
        } else {
          long r2 = row - MP, b = r2 >> 4, tt = r2 & 15;
          dst = p.out + (kk ? oSK : oSV) + ((((long)layer * NSB + b) * HC + head) * SSEQ + tt) * 64;
        }
#pragma unroll
        for (int n = 0; n < 4; ++n)
          __builtin_nontemporal_store(acc[i][n], (f32x4*)(dst + n * 16 + 4 * fq));
      }
    }
  }
}

DI void phase_outproj(int wv, const Params& p, int layer, char* smc) {
  const int otid = opaque_tid(wv);
  const u16* U = (const u16*)(p.ws + wsU);
  const u16* W = (const u16*)(p.ws + wsWOUT) + (size_t)layer * 1024 * 2048;
  const int lane = otid & 63, wave = otid >> 6, wm = wave >> 1, wn = wave & 1;
  const int fr = lane & 15, fq = lane >> 4;
  const int NTN = 8, NTM = MT / 128;
  const int xcd = blockIdx.x & 7, slot = blockIdx.x >> 3, nslots = gridDim.x >> 3;
  const int nmt = (NTM - xcd + 7) >> 3;
  for (int tl = slot; tl < nmt * NTN; tl += nslots) {
    const int tn = tl % NTN, tm = (tl / NTN) * 8 + xcd;
    f32x4 acc[4][4];
    float sc0[4], sc1[4];
    {
      const float* SSQ = (const float*)(p.ws + wsSSQ);
#pragma unroll
      for (int i = 0; i < 4; ++i) {
        const long row = (long)tm * 128 + wm * 64 + i * 16 + fr;
        sc0[i] = rsqrtf(SSQ[row * 2 + 0] * (1.f / 384.f) + 1e-5f);
        sc1[i] = rsqrtf(SSQ[row * 2 + 1] * (1.f / 384.f) + 1e-5f);
      }
    }
    gemm_mainloop(wv, U + (size_t)tm * 128 * 64, 64, (long)MT * 64, W + (size_t)tn * 128 * 2048, 2048, 2048, smc, acc, true, sc0, sc1);
#pragma unroll
    for (int i = 0; i < 4; ++i) {
      const long row = (long)tm * 128 + wm * 64 + i * 16 + fr;
      const float* xi = xrow(p, layer, row);
      float* yo = p.out + row * DM;
#pragma unroll
      for (int n = 0; n < 4; ++n) {
        const int col = tn * 128 + wn * 64 + n * 16 + 4 * fq;
        const f32x4 x4 = __builtin_nontemporal_load((const f32x4*)(xi + col));
        __builtin_nontemporal_store(x4 + acc[i][n], (f32x4*)(yo + col));
      }
    }
  }
}

DI void rwkv_item(int wv, const Params& p, int layer, int b, int h, bool samp, char* smc, bool dry) {
  const int otid = opaque_tid(wv);
  const int tid = otid, lane = tid & 63, w = tid >> 6, fr = lane & 15, fq = lane >> 4;
  const int lt = tid >> 4, lp = tid & 15;
  const int T = samp ? SSEQ : SEQ;
  const long row0 = samp ? (long)MP + b * SSEQ : (long)b * SEQ;
  u16* U = (u16*)(p.ws + wsU);
  float* CL = (float*)smc;
  float* AabF = CL + 2048;
  float* PC = AabF + 512;
  float* RKD = PC + 128;
  u16* ASb = (u16*)(RKD + 32);
  u16* OPA = ASb + 32 * 64;
  u16* OPR = OPA + 32 * 72;
  u16* OPK = OPR + 32 * 72;
  u16* OPB = OPK + 32 * 72;
  u16* VT = OPB + 32 * 72;
  u16* UT = VT + 64 * 40 + 64;
  u16* Sb = UT + 64 * 40;
  u16* Aak = Sb + 64 * 72;
  u16* Ark = Aak + 2 * 16 * 40;
  u16* Arb = Ark + 2 * 16 * 40;
  float* YY = CL;
  u16* TWb = OPK;
  u16* TAb = OPB;
  const float* mu = PW(p, 11) + layer * WSH;
  const float* w2 = PW(p, 13) + (size_t)layer * 64 * DA + h * 64;
  const float* a2 = PW(p, 15) + (size_t)layer * 64 * DA + h * 64;
  const float* shift0 = p.in[3] + ((size_t)layer * NSB + b) * WSH;
  const int hc = layer * DA + h * 64;
  int oc[5];
  float muc[5][4];
#pragma unroll
  for (int seg = 0; seg < 5; ++seg) {
    oc[seg] = (seg < 3 ? seg * 768 + h * 64 : (seg == 3 ? 2304 : 2368)) + 4 * lp;
#pragma unroll
    for (int e = 0; e < 4; ++e) muc[seg][e] = mu[oc[seg] + e];
  }
  float kkc[4], kac[4], rkc[4], lnw[4], lnb[4];
#pragma unroll
  for (int e = 0; e < 4; ++e) {
    kkc[e] = PW(p, 16)[hc + 4 * lp + e];
    kac[e] = PW(p, 17)[hc + 4 * lp + e];
    rkc[e] = PW(p, 18)[hc + 4 * lp + e];
    lnw[e] = PW(p, 19)[hc + 4 * lp + e];
    lnb[e] = PW(p, 20)[hc + 4 * lp + e];
  }
  const float w0c = PW(p, 12)[hc + 16 * w + fr], a0c = PW(p, 14)[hc + 16 * w + fr];
  bf16x8 bw[2], ba[2];
#pragma unroll
  for (int ks = 0; ks < 2; ++ks)
#pragma unroll
    for (int e = 0; e < 8; ++e) {
      const int j = 32 * ks + 8 * fq + e;
      bw[ks][e] = (short)f2bf(w2[(size_t)j * DA + 16 * w + fr]);
      ba[ks][e] = (short)f2bf(a2[(size_t)j * DA + 16 * w + fr]);
    }
  f32x4 Sacc[4];
  __syncthreads();
  {
    const float* s0 = p.in[2] + (((size_t)layer * NSB + b) * HA + h) * 4096;
#pragma unroll
    for (int nt = 0; nt < 4; ++nt)
#pragma unroll
      for (int jj = 0; jj < 4; ++jj) {
        const int i = 16 * w + 4 * fq + jj, j = 16 * nt + fr;
        float v = samp ? s0[i * 64 + j] : 0.f;
        Sacc[nt][jj] = v;
        Sb[i * 72 + j] = f2bf(v);
      }
    for (int id = tid; id < (2 * 64 * 40 + 64) / 2; id += 256) ((unsigned*)VT)[id] = 0u;
    for (int id = tid; id < (3 * 2 * 16 * 40) / 2; id += 256) ((unsigned*)Aak)[id] = 0u;
  }
  u32x2 cu[2][5], pu[2][5], gq[2];
  auto issue_loads = [&](int t0) {
#pragma unroll
    for (int u = 0; u < 2; ++u) {
      const int tt = min(t0 + lt + 16 * u, T - 1);
      const long row = row0 + tt;
#pragma unroll
      for (int seg = 0; seg < 5; ++seg) {
        cu[u][seg] = __builtin_nontemporal_load((const u32x2*)(U + uidx(row, cUA + oc[seg])));
        pu[u][seg] = *(const u32x2*)(U + uidx(tt > 0 ? row - 1 : row, cUA + oc[seg]));
      }
      gq[u] = __builtin_nontemporal_load((const u32x2*)(U + uidx(row, cGA + h * 64 + 4 * lp)));
    }
  };
  issue_loads(0);
  for (int t0 = 0; t0 < T; t0 += 32) {
    int fr_l = fr, fq_l = fq, lt_l = lt, lp_l = lp, w_l = w;
    asm volatile("" : "+v"(fr_l), "+v"(fq_l), "+v"(lt_l), "+v"(lp_l), "+v"(w_l));
    const int fr = fr_l, fq = fq_l, lt = lt_l, lp = lp_l, w = w_l;
    const int nsub = (T - t0) >= 32 ? 2 : 1;
    float rkv[2][3][4];
#pragma unroll
    for (int u = 0; u < 2; ++u) {
      const int tok = lt + 16 * u;
#pragma unroll
      for (int seg = 0; seg < 5; ++seg) {
        float c[4], pv[4], o[4];
        c[0] = __uint_as_float(cu[u][seg][0] << 16); c[1] = __uint_as_float(cu[u][seg][0] & 0xffff0000u);
        c[2] = __uint_as_float(cu[u][seg][1] << 16); c[3] = __uint_as_float(cu[u][seg][1] & 0xffff0000u);
        pv[0] = __uint_as_float(pu[u][seg][0] << 16); pv[1] = __uint_as_float(pu[u][seg][0] & 0xffff0000u);
        pv[2] = __uint_as_float(pu[u][seg][1] << 16); pv[3] = __uint_as_float(pu[u][seg][1] & 0xffff0000u);
        if (t0 + tok == 0) {
#pragma unroll
          for (int e = 0; e < 4; ++e) pv[e] = samp ? shift0[oc[seg] + e] : 0.f;
        }
#pragma unroll
        for (int e = 0; e < 4; ++e) o[e] = c[e] + (pv[e] - c[e]) * muc[seg][e];
        if (seg < 3) {
#pragma unroll
          for (int e = 0; e < 4; ++e) rkv[u][seg][e] = o[e];
        } else {
          if (seg == 3) {
#pragma unroll
            for (int e = 0; e < 4; ++e) o[e] = 1.f - 2.f * frcp(1.f + __expf(2.f * o[e]));
          }
          u32x2 pk;
          pk[0] = pack2(o[0], o[1]);
          pk[1] = pack2(o[2], o[3]);
          *(u32x2*)&(seg == 3 ? TWb : TAb)[tok * 72 + 4 * lp] = pk;
        }
      }
    }
    const u32x2 gate0 = gq[0], gate1 = gq[1];
    issue_loads(min(t0 + 32, T - 1));
    __syncthreads();
#pragma unroll
    for (int u = 0; u < 2; ++u) {
      f32x4 accw = {0.f, 0.f, 0.f, 0.f}, acca = {0.f, 0.f, 0.f, 0.f};
#pragma unroll
      for (int ks = 0; ks < 2; ++ks) {
        accw = MFMA16(ldfrag(TWb, 72, 16 * u + fr, 32 * ks + 8 * fq), bw[ks], accw);
        acca = MFMA16(ldfrag(TAb, 72, 16 * u + fr, 32 * ks + 8 * fq), ba[ks], acca);
      }
      float lw[4], pre[4];
#pragma unroll
      for (int jj = 0; jj < 4; ++jj) {
        float wl = w0c + accw[jj];
        float wlog = -softplusf(-wl) - 0.5f;
        lw[jj] = -__expf(wlog);
      }
      pre[0] = lw[0]; pre[1] = pre[0] + lw[1]; pre[2] = pre[1] + lw[2]; pre[3] = pre[2] + lw[3];
      const float tot = pre[3];
      const float t1 = bperm(tot, lane - 16), t2 = bperm(tot, lane - 32), t3 = bperm(tot, lane - 48);
      const float base = (fq >= 1 ? t1 : 0.f) + (fq >= 2 ? t2 : 0.f) + (fq >= 3 ? t3 : 0.f);
      const int c = 16 * w + fr;
#pragma unroll
      for (int jj = 0; jj < 4; ++jj) {
        const int t = 16 * u + 4 * fq + jj;
        CL[t * 64 + c] = base + pre[jj];
        ASb[t * 64 + c] = f2bf(frcp(1.f + __expf(-(a0c + acca[jj]))));
      }
      if (fq == 3) PC[u * 64 + c] = __expf(base + pre[3]);
    }
    __syncthreads();
#pragma unroll
    for (int u = 0; u < 2; ++u) {
      const int tok = lt + 16 * u;
      const float4 cl4 = *(const float4*)&CL[tok * 64 + 4 * lp];
      float4 cp4 = {0.f, 0.f, 0.f, 0.f};
      if (lt > 0) cp4 = *(const float4*)&CL[(tok - 1) * 64 + 4 * lp];
      const u32x2 as2 = *(const u32x2*)&ASb[tok * 64 + 4 * lp];
      const float av[4] = {__uint_as_float(as2[0] << 16), __uint_as_float(as2[0] & 0xffff0000u), __uint_as_float(as2[1] << 16),
                           __uint_as_float(as2[1] & 0xffff0000u)};
      const float clv[4] = {cl4.x, cl4.y, cl4.z, cl4.w}, cpv[4] = {cp4.x, cp4.y, cp4.z, cp4.w};
      float kk[4], ss = 0.f;
#pragma unroll
      for (int e = 0; e < 4; ++e) { kk[e] = rkv[u][1][e] * kkc[e]; ss += kk[e] * kk[e]; }
      ss = red16(ss);
      const float inv = fminf(__builtin_amdgcn_rsqf(ss), 1e12f);
      float rk = 0.f, oa[4], orr[4], ok[4], ob[4];
#pragma unroll
      for (int e = 0; e < 4; ++e) {
        const float kkn = kk[e] * inv;
        const float kn = rkv[u][1][e] * (1.f + (av[e] - 1.f) * kac[e]);
        rk += rkv[u][0][e] * kn * rkc[e];
        const float P = __expf(clv[e]), Pm1 = __expf(cpv[e]), Pinv = __expf(-clv[e]);
        oa[e] = -kkn * Pm1;
        orr[e] = rkv[u][0][e] * P;
        ok[e] = kn * Pinv;
        ob[e] = kkn * av[e] * Pinv;
        VT[(4 * lp + e) * 40 + (((4 * lp + e) >> 3) << 3) + tok] = f2bf(rkv[u][2][e]);
      }
      rk = red16(rk);
      if (lp == 0) RKD[tok] = rk;
      u32x2 pk;
      pk[0] = pack2(oa[0], oa[1]); pk[1] = pack2(oa[2], oa[3]);
      *(u32x2*)&OPA[tok * 72 + 4 * lp] = pk;
      pk[0] = pack2(orr[0], orr[1]); pk[1] = pack2(orr[2], orr[3]);
      *(u32x2*)&OPR[tok * 72 + 4 * lp] = pk;
      pk[0] = pack2(ok[0], ok[1]); pk[1] = pack2(ok[2], ok[3]);
      *(u32x2*)&OPK[tok * 72 + 4 * lp] = pk;
      pk[0] = pack2(ob[0], ob[1]); pk[1] = pack2(ob[2], ob[3]);
      *(u32x2*)&OPB[tok * 72 + 4 * lp] = pk;
    }
    __syncthreads();
#pragma unroll
    for (int u = 0; u < 2; ++u) {
      const u16* Mop = (w & 2) ? OPR : OPA;
      const u16* Nop = (w & 1) ? OPB : OPK;
      f32x4 g = {0.f, 0.f, 0.f, 0.f};
#pragma unroll
      for (int ks = 0; ks < 2; ++ks)
        g = MFMA16(ldfrag(Mop, 72, 16 * u + fr, 32 * ks + 8 * fq), ldfrag(Nop, 72, 16 * u + fr, 32 * ks + 8 * fq), g);
#pragma unroll
      for (int jj = 0; jj < 4; ++jj) {
        const int t = 4 * fq + jj, s = fr;
        const bool keep = (w & 2) ? (s <= t) : (s < t);
        const float val = keep ? g[jj] : 0.f;
        if (w == 1) AabF[u * 256 + t * 16 + s] = val;
        else (w == 0 ? Aak : (w == 2 ? Ark : Arb))[u * 640 + t * 40 + 16 * u + s] = f2bf(val);
      }
    }
    __syncthreads();
    for (int u = 0; u < nsub; ++u) {
      const int ib = 16 * w + fr;
      const u16* VTr = VT + ((ib >> 3) << 3);
      f32x4 x = {0.f, 0.f, 0.f, 0.f};
#pragma unroll
      for (int ks = 0; ks < 2; ++ks) x = MFMA16(ldfrag(OPA, 72, 16 * u + fr, 32 * ks + 8 * fq), ldfrag(Sb, 72, ib, 32 * ks + 8 * fq), x);
      x = MFMA16(ldfrag(Aak + u * 640, 40, fr, 8 * fq), ldfrag(VTr, 40, ib, 8 * fq), x);
      const float* Af = AabF + u * 256;
      float xv[4] = {x[0], x[1], x[2], x[3]};
      float4 dg[4];
#pragma unroll
      for (int jj = 0; jj < 4; ++jj) dg[jj] = *(const float4*)&Af[(4 * fq + jj) * 16 + 4 * fq];
#pragma unroll
      for (int g = 0; g < 4; ++g) {
        if (fq == g) {
          xv[1] += dg[1].x * xv[0];
          xv[2] += dg[2].x * xv[0] + dg[2].y * xv[1];
          xv[3] += dg[3].x * xv[0] + dg[3].y * xv[1] + dg[3].z * xv[2];
        }
        if (g < 3) {
          float ug[4];
#pragma unroll
          for (int e = 0; e < 4; ++e) ug[e] = bperm(xv[e], fr + 16 * g);
          if (fq > g) {
#pragma unroll
            for (int jj = 0; jj < 4; ++jj) {
              const float4 c4 = *(const float4*)&Af[(4 * fq + jj) * 16 + 4 * g];
              xv[jj] += c4.x * ug[0] + c4.y * ug[1] + c4.z * ug[2] + c4.w * ug[3];
            }
          }
        }
      }
      {
        u32x2 pk;
        pk[0] = pack2(xv[0], xv[1]);
        pk[1] = pack2(xv[2], xv[3]);
        *(u32x2*)&UT[ib * 40 + 16 * u + 4 * fq] = pk;
      }
      f32x4 y = {0.f, 0.f, 0.f, 0.f};
#pragma unroll
      for (int ks = 0; ks < 2; ++ks) y = MFMA16(ldfrag(OPR, 72, 16 * u + fr, 32 * ks + 8 * fq), ldfrag(Sb, 72, ib, 32 * ks + 8 * fq), y);
      y = MFMA16(ldfrag(Ark + u * 640, 40, fr, 8 * fq), ldfrag(VTr, 40, ib, 8 * fq), y);
      y = MFMA16(ldfrag(Arb + u * 640, 40, fr, 8 * fq), ldfrag(UT, 40, ib, 8 * fq), y);
#pragma unroll
      for (int jj = 0; jj < 4; ++jj) YY[(16 * u + 4 * fq + jj) * 64 + ib] = y[jj];
      const bf16x8 af = (fq < 2) ? ldfrag(VTr, 40, ib, 16 * u + 8 * fq) : ldfrag(UT, 40, ib, 16 * u + 8 * (fq - 2));
      const u16* src = (fq < 2) ? OPK : OPB;
      const int s0 = 16 * u + (fq & 1) * 8;
#pragma unroll
      for (int nt = 0; nt < 4; ++nt) {
        bf16x8 bfg;
#pragma unroll
        for (int e = 0; e < 8; ++e) bfg[e] = (short)src[(s0 + e) * 72 + 16 * nt + fr];
        Sacc[nt] = MFMA16(af, bfg, Sacc[nt]);
        const float pc = PC[u * 64 + 16 * nt + fr];
#pragma unroll
        for (int jj = 0; jj < 4; ++jj) {
          Sacc[nt][jj] *= pc;
          Sb[(16 * w + 4 * fq + jj) * 72 + 16 * nt + fr] = f2bf(Sacc[nt][jj]);
        }
      }
    }
    __syncthreads();
#pragma unroll
    for (int u = 0; u < 2; ++u) {
      const int tok = lt + 16 * u;
      const float4 y4 = *(const float4*)&YY[tok * 64 + 4 * lp];
      const float y[4] = {y4.x, y4.y, y4.z, y4.w};
      float s1 = y[0] + y[1] + y[2] + y[3];
      s1 = red16(s1);
      const float mean = s1 * (1.f / 64.f);
      float s2 = 0.f;
#pragma unroll
      for (int e = 0; e < 4; ++e) { const float d = y[e] - mean; s2 += d * d; }
      s2 = red16(s2);
      const float rstd = rsqrtf(s2 * (1.f / 64.f) + 64e-5f);
      const float rkd = RKD[tok];
      const u32x2 gate = u ? gate1 : gate0;
      const float g[4] = {__uint_as_float(gate[0] << 16), __uint_as_float(gate[0] & 0xffff0000u),
                          __uint_as_float(gate[1] << 16), __uint_as_float(gate[1] & 0xffff0000u)};
      float o[4];
#pragma unroll
      for (int e = 0; e < 4; ++e) o[e] = ((y[e] - mean) * rstd * lnw[e] + lnb[e] + rkd * rkv[u][2][e]) * silu(g[e]);
      u32x2 pk;
      pk[0] = pack2(o[0], o[1]);
      pk[1] = pack2(o[2], o[3]);
      if (!dry && u < nsub) *(u32x2*)(U + uidx(row0 + t0 + tok, cGA + h * 64 + 4 * lp)) = pk;
    }
    __syncthreads();
  }
  if (!dry) {
    float* so = p.out + (samp ? oSRW + (((size_t)layer * NSB + b) * HA + h) * 4096 : oPRW + (((size_t)layer * NB + b) * HA + h) * 4096);
#pragma unroll
    for (int nt = 0; nt < 4; ++nt)
#pragma unroll
      for (int jj = 0; jj < 4; ++jj) so[(16 * w + 4 * fq + jj) * 64 + 16 * nt + fr] = Sacc[nt][jj];
    float* sh = p.out + (samp ? oSSH + ((size_t)layer * NSB + b) * WSH : oPSH + ((size_t)layer * NB + b) * WSH);
    if (tid < 192) {
      int col = (tid >> 6) * 768 + h * 64 + (tid & 63);
      sh[col] = bf2f(U[uidx(row0 + T - 1, cUA + col)]);
    }
    if (h == 0 && tid < 128) sh[2304 + tid] = bf2f(U[uidx(row0 + T - 1, cUA + 2304 + tid)]);
  }
}

DI void phase_conv(int wv, const Params& p, int layer) {
  const int otid = opaque_tid(wv);
  const int tid = otid;
  u16* U = (u16*)(p.ws + wsU);
  const int c8 = tid & 7, run = tid >> 3;
  const int NITEM = NB * 20 + NSB * 20;
  for (int it = blockIdx.x; it < NITEM; it += gridDim.x) {
    const bool samp = it >= NB * 20;
    const int ii = samp ? it - NB * 20 : it;
    const int b = ii / 20, cb = ii % 20;
    const int T = samp ? SSEQ : SEQ;
    const int RL = samp ? 1 : 128;
    const bool active = samp ? (run < 16) : true;
    const long row0 = samp ? (long)MP + b * SSEQ : (long)b * SEQ;
    const int chan = cb * 64 + c8 * 8;
    const float* cw = PW(p, 21) + (size_t)layer * 4 * CD + chan;
    const float* cbp = PW(p, 22) + layer * CD + chan;
    const float* conv0 = p.in[5] + ((size_t)layer * NSB + b) * 3 * CD + chan;
    float* co = p.out + (samp ? oSCV + ((size_t)layer * NSB + b) * 3 * CD : oPCV + ((size_t)layer * NB + b) * 3 * CD) + chan;
    float cwr[4][8], cbr[8];
#pragma unroll
    for (int e = 0; e < 8; ++e) {
      cbr[e] = cbp[e];
#pragma unroll
      for (int i = 0; i < 4; ++i) cwr[i][e] = cw[i * CD + e];
    }
    const int tstart = run * RL;
    u16* colp = U + uidx(row0, cXBC + chan);
    u32x4 w0 = {0u, 0u, 0u, 0u}, w1 = w0, w2 = w0;
    if (active) {
      if (tstart >= 3) {
        w0 = *(const u32x4*)(colp + (long)(tstart - 3) * 64);
        w1 = *(const u32x4*)(colp + (long)(tstart - 2) * 64);
        w2 = *(const u32x4*)(colp + (long)(tstart - 1) * 64);
      } else if (samp) {
#pragma unroll
        for (int i = 0; i < 3; ++i) {
          const int tt = tstart - 3 + i;
          u32x4 v;
          if (tt >= 0) v = *(const u32x4*)(colp + (long)tt * 64);
          else {
#pragma unroll
            for (int e = 0; e < 4; ++e) v[e] = pack2(conv0[(tt + 3) * CD + 2 * e], conv0[(tt + 3) * CD + 2 * e + 1]);
          }
          if (i == 0) w0 = v; else if (i == 1) w1 = v; else w2 = v;
        }
      }
    }
    __syncthreads();
    if (active) {
      for (int tb = tstart; tb < tstart + RL; tb += 4) {
        u32x4 wn[4];
#pragma unroll
        for (int u = 0; u < 4; ++u)
          if (tb + u < tstart + RL) wn[u] = __builtin_nontemporal_load((const u32x4*)(colp + (long)(tb + u) * 64));
#pragma unroll
        for (int u = 0; u < 4; ++u) {
          const int t = tb + u;
          if (t < tstart + RL) {
            const u32x4 w3 = wn[u];
        float val[8];
#pragma unroll
            for (int e = 0; e < 4; ++e) {
              val[2 * e] = cbr[2 * e] + cwr[0][2 * e] * __uint_as_float(w0[e] << 16) + cwr[1][2 * e] * __uint_as_float(w1[e] << 16) +
                           cwr[2][2 * e] * __uint_as_float(w2[e] << 16) + cwr[3][2 * e] * __uint_as_float(w3[e] << 16);
              val[2 * e + 1] = cbr[2 * e + 1] + cwr[0][2 * e + 1] * __uint_as_float(w0[e] & 0xffff0000u) +
                               cwr[1][2 * e + 1] * __uint_as_float(w1[e] & 0xffff0000u) + cwr[2][2 * e + 1] * __uint_as_float(w2[e] & 0xffff0000u) +
                               cwr[3][2 * e + 1] * __uint_as_float(w3[e] & 0xffff0000u);
            }
            u32x4 pk;
#pragma unroll
            for (int e = 0; e < 4; ++e) pk[e] = pack2(silu(val[2 * e]), silu(val[2 * e + 1]));
            *(u32x4*)(colp + (long)t * 64) = pk;
            if (t >= T - 3) {
              float* d = co + (t - (T - 3)) * CD;
#pragma unroll
              for (int e = 0; e < 4; ++e) {
                d[2 * e] = __uint_as_float(w3[e] << 16);
                d[2 * e + 1] = __uint_as_float(w3[e] & 0xffff0000u);
              }
            }
            w0 = w1; w1 = w2; w2 = w3;
          }
        }
      }
    }
    __syncthreads();
  }
}

DI void mamba_item(int wv, const Params& p, int layer, int b, int h, bool samp, char* smc, bool dry) {
  const int otid = opaque_tid(wv);
  const int tid = otid, lane = tid & 63, wave = tid >> 6, fr = lane & 15, fq = lane >> 4;
  const int T = samp ? SSEQ : SEQ;
  const long row0 = samp ? (long)MP + b * SSEQ : (long)b * SEQ;
  const int g = h / HPG;
  u16* U = (u16*)(p.ws + wsU);
  float* SSQ = (float*)(p.ws + wsSSQ);
  u16* Cm = (u16*)smc;
  u16* Bm = Cm + 32 * 136;
  u16* Xd = Bm + 32 * 136;
  u16* Xe = Xd + 32 * 72;
  u16* Mx = Xe + 32 * 72;
  u16* Sb = Mx + 32 * 40;
  u16* Zs = Sb + 64 * 136;
  float* fdt = (float*)(Zs + 32 * 72);
  float* fac = fdt + 32;
  float* fde = fac + 32;
  const float dtb = PW(p, 23)[layer * HB + h];
  const float Aneg = -__expf(PW(p, 24)[layer * HB + h]);
  const float Dh = PW(p, 25)[layer * HB + h];
  const int zt = tid >> 3, zc = (tid & 7) * 8;
  const int br = tid >> 4, bc = (tid & 15) * 8;
  const u16* xsp = U + uidx(row0, cXBC + h * 64 + zc);
  const u16* zp = U + uidx(row0, cZB + h * 64 + zc);
  const u16* bp0 = U + uidx(row0, cXBC + 768 + g * 128 + bc);
  const u16* cp0 = U + uidx(row0, cXBC + 1024 + g * 128 + bc);
  const u16* dtp = U + uidx(row0, cDT + h);
  f32x4 Sacc[8];
  __syncthreads();
  {
    const float* s0 = p.in[4] + (((size_t)layer * NSB + b) * HB + h) * 64 * DS;
#pragma unroll
    for (int nt = 0; nt < 8; ++nt)
#pragma unroll
      for (int j = 0; j < 4; ++j) {
        int pp = 16 * wave + 4 * fq + j, n = 16 * nt + fr;
        float v = samp ? s0[pp * DS + n] : 0.f;
        Sacc[nt][j] = v;
        Sb[pp * 136 + n] = f2bf(v);
      }
  }
  u32x4 xr, zr, br0, br1, cr0, cr1;
  float dtr = 0.f;
  auto issue = [&](int t0) {
    const u32x4 z4 = {0u, 0u, 0u, 0u};
    xr = zr = br0 = br1 = cr0 = cr1 = z4;
    if (t0 + zt < T) {
      xr = __builtin_nontemporal_load((const u32x4*)(xsp + (long)(t0 + zt) * 64));
      zr = __builtin_nontemporal_load((const u32x4*)(zp + (long)(t0 + zt) * 64));
    }
    if (t0 + br < T) {
      br0 = *(const u32x4*)(bp0 + (long)(t0 + br) * 64);
      cr0 = *(const u32x4*)(cp0 + (long)(t0 + br) * 64);
    }
    if (t0 + br + 16 < T) {
      br1 = *(const u32x4*)(bp0 + (long)(t0 + br + 16) * 64);
      cr1 = *(const u32x4*)(cp0 + (long)(t0 + br + 16) * 64);
    }
    if (tid < 32) dtr = (t0 + tid < T) ? bf2f(dtp[(long)(t0 + tid) * 64]) : 0.f;
  };
  issue(0);
  for (int t0 = 0; t0 < T; t0 += 32) {
    const int nv = min(32, T - t0);
    if (tid < 32) {
      const int t = tid;
      float dt = (t < nv) ? softplusf(dtr + dtb) : 0.f;
      float a = dt * Aneg;
#pragma unroll
      for (int o = 1; o < 32; o <<= 1) {
        float v = bperm(a, t - o);
        if (t >= o) a += v;
      }
      float last = bperm(a, 31);
      fdt[t] = dt; fac[t] = a; fde[t] = __expf(last - a);
    }
    *(u32x4*)&Bm[br * 136 + bc] = br0;
    *(u32x4*)&Bm[(br + 16) * 136 + bc] = br1;
    *(u32x4*)&Cm[br * 136 + bc] = cr0;
    *(u32x4*)&Cm[(br + 16) * 136 + bc] = cr1;
    *(u32x4*)&Zs[zt * 72 + zc] = zr;
    __syncthreads();
    {
      const float dt = fdt[zt], dde = dt * fde[zt];
      u32x4 pk, pe;
#pragma unroll
      for (int e = 0; e < 4; ++e) {
        const float lo = __uint_as_float(xr[e] << 16), hi = __uint_as_float(xr[e] & 0xffff0000u);
        pk[e] = pack2(lo * dt, hi * dt);
        pe[e] = pack2(lo * dde, hi * dde);
      }
      *(u32x4*)&Xd[zt * 72 + zc] = pk;
      *(u32x4*)&Xe[zt * 72 + zc] = pe;
    }
    {
      const int mq = wave >> 1, ns = wave & 1;
      f32x4 G = {0.f, 0.f, 0.f, 0.f};
#pragma unroll
      for (int ks = 0; ks < 4; ++ks)
        G = MFMA16(ldfrag(Cm, 136, 16 * mq + fr, 32 * ks + 8 * fq), ldfrag(Bm, 136, 16 * ns + fr, 32 * ks + 8 * fq), G);
#pragma unroll
      for (int j = 0; j < 4; ++j) {
        const int q = 16 * mq + 4 * fq + j, s = 16 * ns + fr;
        float m = (s <= q) ? G[j] * __expf(fac[q] - fac[s]) : 0.f;
        Mx[q * 40 + s] = f2bf(m);
      }
    }
    if (t0 + 32 < T) issue(t0 + 32);
    __syncthreads();
    {
      const int mq = wave >> 1;
      float ssq[4] = {0.f, 0.f, 0.f, 0.f};
#pragma unroll
      for (int pi = 0; pi < 2; ++pi) {
        const int pt = (wave & 1) * 2 + pi;
        f32x4 yd = {0.f, 0.f, 0.f, 0.f}, yo = {0.f, 0.f, 0.f, 0.f};
        {
          bf16x8 xg;
#pragma unroll
          for (int e = 0; e < 8; ++e) xg[e] = (short)Xd[(8 * fq + e) * 72 + 16 * pt + fr];
          yd = MFMA16(ldfrag(Mx, 40, 16 * mq + fr, 8 * fq), xg, yd);
        }
#pragma unroll
        for (int ks = 0; ks < 4; ++ks)
          yo = MFMA16(ldfrag(Cm, 136, 16 * mq + fr, 32 * ks + 8 * fq), ldfrag(Sb, 136, 16 * pt + fr, 32 * ks + 8 * fq), yo);
#pragma unroll
        for (int j = 0; j < 4; ++j) {
          const int q = 16 * mq + 4 * fq + j, pp = 16 * pt + fr;
          if (q < nv) {
            float y = yd[j] + __expf(fac[q]) * yo[j] + Dh * bf2f(Xd[q * 72 + pp]) * frcp(fdt[q]);
            float o = y * silu(bf2f(Zs[q * 72 + pp]));
            Zs[q * 72 + pp] = f2bf(o);
            ssq[j] += o * o;
          }
        }
      }
#pragma unroll
      for (int j = 0; j < 4; ++j) {
        float s = red16(ssq[j]);
        const int q = 16 * mq + 4 * fq + j;
        if (!dry && fr == 0 && q < nv) atomicAdd(&SSQ[(row0 + t0 + q) * 2 + g], s);
      }
    }
    {
      const float cd = __expf(fac[31]);
      bf16x8 a;
#pragma unroll
      for (int e = 0; e < 8; ++e) a[e] = (short)Xe[(8 * fq + e) * 72 + 16 * wave + fr];
#pragma unroll
      for (int nt = 0; nt < 8; ++nt) {
        bf16x8 bg;
#pragma unroll
        for (int e = 0; e < 8; ++e) bg[e] = (short)Bm[(8 * fq + e) * 136 + 16 * nt + fr];
#pragma unroll
        for (int j = 0; j < 4; ++j) Sacc[nt][j] *= cd;
        Sacc[nt] = MFMA16(a, bg, Sacc[nt]);
      }
    }
    __syncthreads();
#pragma unroll
    for (int nt = 0; nt < 8; ++nt)
#pragma unroll
      for (int j = 0; j < 4; ++j) Sb[(16 * wave + 4 * fq + j) * 136 + 16 * nt + fr] = f2bf(Sacc[nt][j]);
    if (!dry && zt < nv) *(u32x4*)(U + uidx(row0 + t0 + zt, cZB + h * 64 + zc)) = *(const u32x4*)&Zs[zt * 72 + zc];
    __syncthreads();
  }
  if (!dry) {
    float* so = p.out + (samp ? oSSS + (((size_t)layer * NSB + b) * HB + h) * 64 * DS : oPSS + (((size_t)layer * NB + b) * HB + h) * 64 * DS);
#pragma unroll
    for (int nt = 0; nt < 8; ++nt)
#pragma unroll
      for (int j = 0; j < 4; ++j) so[(16 * wave + 4 * fq + j) * DS + 16 * nt + fr] = Sacc[nt][j];
  }
}

DI void sb_item(int wv, const Params& p, int layer, int b, int h, int qb, bool samp, char* smc, bool dry) {
  const int otid = opaque_tid(wv);
  const int tid = otid, lane = tid & 63, wave = tid >> 6, fr = lane & 15, fq = lane >> 4;
  u16* U = (u16*)(p.ws + wsU);
  u16* Qs = (u16*)smc;
  u16* Ks = Qs + 64 * 72;
  u16* VT = Ks + 64 * 72;
  u16* Ps = VT + 64 * 72 + 128;
  float* flag = (float*)(Ps + 64 * 72);
  const int nq = samp ? SSEQ : 64;
  const int qpos0 = samp ? PAST : 64 * qb;
  const long rowq0 = samp ? (long)MP + b * SSEQ : (long)b * SEQ + 64 * qb;
  const int ktlast = samp ? 16 : qb;
  const float* kbase = samp ? p.in[6] + (((size_t)layer * NSB + b) * HC + h) * PAST * 64
                            : p.out + oPK + (((size_t)layer * NB + b) * HC + h) * SEQ * 64;
  const float* vbase = samp ? p.in[7] + (((size_t)layer * NSB + b) * HC + h) * PAST * 64
                            : p.out + oPV + (((size_t)layer * NB + b) * HC + h) * SEQ * 64;
  const float* knew = p.out + oSK + (((size_t)layer * NSB + b) * HC + h) * SSEQ * 64;
  const float* vnew = p.out + oSV + (((size_t)layer * NSB + b) * HC + h) * SSEQ * 64;
  __syncthreads();
#pragma unroll
  for (int i = 0; i < 2; ++i) {
    const int id = tid + 256 * i, r = id >> 3, c8 = id & 7;
    u32x4 v = {0u, 0u, 0u, 0u};
    if (r < nq) v = *(const u32x4*)(U + uidx(rowq0 + r, cQ + h * 64 + c8 * 8));
    *(u32x4*)(Qs + r * 72 + c8 * 8) = v;
  }
  float carry[4] = {0.f, 0.f, 0.f, 0.f};
  f32x4 O[4];
#pragma unroll
  for (int i = 0; i < 4; ++i) O[i] = f32x4{0.f, 0.f, 0.f, 0.f};
  int itn = 0;
  float4 kr[4], vr[4];
  auto fetch = [&](int kt) {
#pragma unroll
    for (int i = 0; i < 4; ++i) {
      const int id = tid + 256 * i, r = id >> 4, c4 = id & 15;
      const int key = 64 * (kt < 0 ? 0 : kt) + r;
      const float* kp;
      const float* vp;
      if (!samp || key < PAST) { kp = kbase + (size_t)key * 64; vp = vbase + (size_t)key * 64; }
      else { const int kn = min(key - PAST, SSEQ - 1); kp = knew + (size_t)kn * 64; vp = vnew + (size_t)kn * 64; }
      kr[i] = *(const float4*)(kp + c4 * 4);
      vr[i] = *(const float4*)(vp + c4 * 4);
    }
  };
  fetch(ktlast);
  for (int kt = ktlast; kt >= 0; --kt, ++itn) {
    __syncthreads();
    if (kt != ktlast) {
      const float* fl = flag + ((itn - 1) & 1) * 4;
      float m = fmaxf(fmaxf(fl[0], fl[1]), fmaxf(fl[2], fl[3]));
      if (m < -104.f) break;
    }
#pragma unroll
    for (int i = 0; i < 4; ++i) {
      const int id = tid + 256 * i, r = id >> 4, c4 = id & 15;
      const int key = 64 * kt + r;
      float4 kv = kr[i], vv = vr[i];
      if (samp && key >= PAST + SSEQ) { kv = float4{0.f, 0.f, 0.f, 0.f}; vv = kv; }
      u32x2 kw;
      kw[0] = pack2(kv.x, kv.y);
      kw[1] = pack2(kv.z, kv.w);
      *(u32x2*)(Ks + r * 72 + c4 * 4) = kw;
      VT[(c4 * 4 + 0) * 72 + c4 * 8 + r] = f2bf(vv.x);
      VT[(c4 * 4 + 1) * 72 + c4 * 8 + r] = f2bf(vv.y);
      VT[(c4 * 4 + 2) * 72 + c4 * 8 + r] = f2bf(vv.z);
      VT[(c4 * 4 + 3) * 72 + c4 * 8 + r] = f2bf(vv.w);
    }
    fetch(kt - 1);
    __syncthreads();
    f32x4 z[4];
#pragma unroll
    for (int n = 0; n < 4; ++n) z[n] = f32x4{0.f, 0.f, 0.f, 0.f};
#pragma unroll
    for (int ks = 0; ks < 2; ++ks) {
      bf16x8 a = ldfrag(Qs, 72, 16 * wave + fr, 32 * ks + 8 * fq);
#pragma unroll
      for (int n = 0; n < 4; ++n) z[n] = MFMA16(a, ldfrag(Ks, 72, 16 * n + fr, 32 * ks + 8 * fq), z[n]);
    }
    float cmax = -1e30f;
#pragma unroll
    for (int j = 0; j < 4; ++j) {
      const int ql = 16 * wave + 4 * fq + j;
      const int qpos = qpos0 + ql;
      float lk[4], sfx[4], tot[4];
#pragma unroll
      for (int n = 0; n < 4; ++n) {
        const int kpos = 64 * kt + 16 * n + fr;
        lk[n] = (kpos < qpos) ? -softplusf(z[n][j]) : 0.f;
        float v = lk[n];
        v += dppf<0x101>(v);
        v += dppf<0x102>(v);
        v += dppf<0x104>(v);
        v += dppf<0x108>(v);
        sfx[n] = v;
        tot[n] = swzf<0x0010>(v);
      }
      float later = carry[j];
#pragma unroll
      for (int n = 3; n >= 0; --n) {
        const int kpos = 64 * kt + 16 * n + fr;
        float tail = (sfx[n] - lk[n]) + later;
        float att = (kpos < qpos) ? __expf(z[n][j] + lk[n] + tail) : 0.f;
        Ps[ql * 72 + 16 * n + fr] = f2bf(att);
        later += tot[n];
      }
      carry[j] = later;
      if (ql < nq) cmax = fmaxf(cmax, later);
    }
    cmax = fmaxf(cmax, dppf<0x128>(cmax)); cmax = fmaxf(cmax, dppf<0x124>(cmax)); cmax = fmaxf(cmax, dppf<0x122>(cmax)); cmax = fmaxf(cmax, dppf<0x121>(cmax));
    cmax = fmaxf(cmax, sx16(cmax)); cmax = fmaxf(cmax, bperm(cmax, lane ^ 32));
    if (lane == 0) flag[(itn & 1) * 4 + wave] = cmax;
#pragma unroll
    for (int ks = 0; ks < 2; ++ks) {
      bf16x8 a = ldfrag(Ps, 72, 16 * wave + fr, 32 * ks + 8 * fq);
#pragma unroll
      for (int dn = 0; dn < 4; ++dn) O[dn] = MFMA16(a, ldfrag(VT + (((16 * dn + fr) >> 2) << 3), 72, 16 * dn + fr, 32 * ks + 8 * fq), O[dn]);
    }
  }
#pragma unroll
  for (int j = 0; j < 4; ++j) {
    const int ql = 16 * wave + 4 * fq + j;
    if (!dry && ql < nq) {
#pragma unroll
      for (int dn = 0; dn < 4; ++dn) {
        u16* gp = U + uidx(rowq0 + ql, cGC + h * 64 + 16 * dn + fr);
        *gp = f2bf(O[dn][j] * silu(bf2f(*gp)));
      }
    }
  }
}

constexpr int IT_RP = NB * HA, IT_MP = NB * HB, IT_RS = NSB * HA, IT_MS = NSB * HB, IT_SS = NSB * HC, IT_SP = NB * HC * (SEQ / 64);
constexpr int NITEMS = IT_RP + IT_MP + IT_RS + IT_MS + IT_SS + IT_SP;
DI void phase_mixers(int wv, const Params& p, int layer, char* smc, int dryType) {
  const int otid = opaque_tid(wv);
  __shared__ int s_item;
  int* cnt = (int*)(p.ws + wsCNT) + layer + (dryType >= 0 ? 2 : 0);
  const bool dry = dryType >= 0;
  for (;;) {
    __syncthreads();
    if (otid == 0) s_item = atomicAdd(cnt, 1);
    __syncthreads();
    int it = s_item;
    if (it >= NITEMS) break;
    int type, b, h, qb = 0; bool samp = false;
    if (it < IT_RP) { type = 0; b = it / HA; h = it % HA; }
    else if ((it -= IT_RP) < IT_MP) { type = 1; b = it / HB; h = it % HB; }
    else if ((it -= IT_MP) < IT_RS) { type = 0; samp = true; b = it / HA; h = it % HA; }
    else if ((it -= IT_RS) < IT_MS) { type = 1; samp = true; b = it / HB; h = it % HB; }
    else if ((it -= IT_MS) < IT_SS) { type = 2; samp = true; b = it / HC; h = it % HC; }
    else { it -= IT_SS; type = 2; qb = it % (SEQ / 64); int bh = it / (SEQ / 64); b = bh / HC; h = bh % HC; }
#ifndef ITEMS
#define ITEMS 7
#endif
    if (dry && type != dryType) continue;
    if (type == 0) { if (ITEMS & 1) { __builtin_amdgcn_s_setprio(3); rwkv_item(wv, p, layer, b, h, samp, smc, dry); __builtin_amdgcn_s_setprio(0); } }
    else if (type == 1) { if (ITEMS & 2) mamba_item(wv, p, layer, b, h, samp, smc, dry); }
    else { if (ITEMS & 4) sb_item(wv, p, layer, b, h, qb, samp, smc, dry); }
  }
}

DI void phase_mnorm(int wv, const Params& p) {
  const int otid = opaque_tid(wv);
  u16* U = (u16*)(p.ws + wsU);
  const float* SSQ = (const float*)(p.ws + wsSSQ);
  const long total = (long)MT * 96;
  for (long i = (long)blockIdx.x * 256 + otid; i < total; i += (long)gridDim.x * 256) {
    long row = i / 96;
    int c8 = (int)(i % 96), g = c8 / 48;
    float rs = rsqrtf(SSQ[row * 2 + g] * (1.f / 384.f) + 1e-5f);
    u32x4* ptr = (u32x4*)(U + uidx(row, cZB + c8 * 8));
    u32x4 v = *ptr;
#pragma unroll
    for (int e = 0; e < 4; ++e) {
      float lo = __uint_as_float(v[e] << 16) * rs, hi = __uint_as_float(v[e] & 0xffff0000u) * rs;
      v[e] = pack2(lo, hi);
    }
    *ptr = v;
  }
}

__global__ void __launch_bounds__(256, 2) fwd_kernel(Params p, int ph_lo, int ph_hi, int coop) {
  __shared__ __attribute__((aligned(16))) char smc[65536 - 64];
  const int wv = __builtin_amdgcn_readfirstlane(threadIdx.x >> 6);
#ifndef ONLY
#define ONLY 255
#endif
#define RUN(PH, BIT, CALL) if (ph_lo <= (PH) && (PH) <= ph_hi) { if (ONLY & (BIT)) { CALL; } if ((PH) < ph_hi && coop) cg::this_grid().sync(); }
  RUN(0, 1, phase_wprep(wv, p, smc))
#pragma unroll
  for (int layer = 0; layer < 2; ++layer) {
    const int pb = 1 + 5 * layer;
    RUN(pb + 0, 2, phase_norm(wv, p, layer))
    RUN(pb + 1, 4, phase_inproj(wv, p, layer, smc))
    RUN(pb + 2, 64, phase_conv(wv, p, layer))
#ifdef DRYTYPE
    if (ph_lo <= pb + 3 && pb + 3 <= ph_hi) {
#pragma unroll 1
      for (int pass = 0; pass < 2; ++pass) {
        phase_mixers(wv, p, layer, smc, pass == 0 ? DRYTYPE : -1);
        if (coop) cg::this_grid().sync();
      }
    }
#else
    RUN(pb + 3, 8, phase_mixers(wv, p, layer, smc, -1))
#endif
    RUN(pb + 4, 32, phase_outproj(wv, p, layer, smc))
  }
}

extern "C" void kernel_launch(void* const* d_in, const int* in_sizes, int n_in, void* d_out, int out_size, void* d_ws,
                              size_t ws_size, hipStream_t stream) {
  static int grid_blocks = 0;
  if (!grid_blocks) {
    int dev = 0, cus = 0, per_cu = 0;
    hipGetDevice(&dev);
    hipDeviceGetAttribute(&cus, hipDeviceAttributeMultiprocessorCount, dev);
    hipOccupancyMaxActiveBlocksPerMultiprocessor(&per_cu, fwd_kernel, 256, 0);
    if (per_cu < 1) per_cu = 1;
    if (per_cu > 2) per_cu = 2;
    grid_blocks = cus * per_cu;
  }
  Params p{};
  for (int i = 0; i < 29; ++i) p.in[i] = (const float*)d_in[i];
  p.out = (float*)d_out;
  p.ws = (char*)d_ws;
#ifdef MULTI_LAUNCH
  for (int ph = 0; ph <= 10; ++ph) {
    hipLaunchKernelGGL(fwd_kernel, dim3(grid_blocks), dim3(256), 0, stream, p, ph, ph, 0);
  }
#else
  int lo = 0, hi = 10, coop = 1;
  void* args[] = {&p, &lo, &hi, &coop};
  hipError_t e = hipLaunchCooperativeKernel((void*)fwd_kernel, dim3(grid_blocks), dim3(256), args, 0, stream);
  if (e != hipSuccess) fprintf(stderr, "cooperative launch failed: %s (grid %d)\n", hipGetErrorString(e), grid_blocks);
#endif
}
```

```cpp
#include <hip/hip_runtime.h>
#include <hip/hip_cooperative_groups.h>
#include <cstdio>
namespace cg = cooperative_groups;

typedef unsigned short u16;
typedef __attribute__((ext_vector_type(8))) short bf16x8;
typedef __attribute__((ext_vector_type(4))) float f32x4;
typedef __attribute__((ext_vector_type(4))) unsigned u32x4;
typedef __attribute__((ext_vector_type(2))) unsigned u32x2;
#define DI __device__ __forceinline__

constexpr int DM = 1024, NB = 16, SEQ = 4096, NSB = 32, SSEQ = 16, PAST = 1024;
constexpr int MP = NB * SEQ, MS = NSB * SSEQ, MT = MP + MS;
constexpr int DA = 768, HA = 12, DB = 768, HB = 12, HPG = 6, DS = 128, CD = 1280, DC = 512, HC = 8;
constexpr int WSH = 2432;
constexpr int O1 = 2432, O2 = 3200, O3 = 3968, O4 = 5248, O5 = 5260, O6 = 5772, O7 = 6284, O8 = 6796, NIN = 7308;
constexpr int NP = 7424, NU = 6400;
constexpr int cGA = 0, cZB = 768, cGC = 1536, cUA = 2048, cXBC = 4480, cQ = 5760, cDT = 6272, cK = 6400, cV = 6912;
constexpr long oYP = 0;
constexpr long oYS = oYP + (long)MP * DM;
constexpr long oPRW = oYS + (long)MS * DM;
constexpr long oPSH = oPRW + 2L * NB * HA * 64 * 64;
constexpr long oPSS = oPSH + 2L * NB * WSH;
constexpr long oPCV = oPSS + 2L * NB * HB * 64 * DS;
constexpr long oPK = oPCV + 2L * NB * 3 * CD;
constexpr long oPV = oPK + 2L * NB * HC * SEQ * 64;
constexpr long oSRW = oPV + 2L * NB * HC * SEQ * 64;
constexpr long oSSH = oSRW + 2L * NSB * HA * 64 * 64;
constexpr long oSSS = oSSH + 2L * NSB * WSH;
constexpr long oSCV = oSSS + 2L * NSB * HB * 64 * DS;
constexpr long oSK = oSCV + 2L * NSB * 3 * CD;
constexpr long oSV = oSK + 2L * NSB * HC * SSEQ * 64;
constexpr size_t wsWIN = 0;
constexpr size_t wsWOUT = wsWIN + 2ull * NP * 1024 * 2;
constexpr size_t wsXN = wsWOUT + 2ull * 1024 * 2048 * 2;
constexpr size_t wsU = wsXN + (size_t)MT * 1024 * 2;
constexpr size_t wsSSQ = wsU + (size_t)MT * NU * 2;
constexpr size_t wsCNT = wsSSQ + (size_t)MT * 2 * 4;
constexpr size_t wsEND = wsCNT + 256;

constexpr int PW_N = 19;
__device__ __constant__ int pw_idx[PW_N] = {8,11,12,13,14,15,16,17,18,19,20,21,22,23,24,25,26,27,28};
__device__ __constant__ int pw_size[PW_N] = {2048,4864,1536,98304,1536,98304,1536,1536,1536,1536,1536,10240,2560,24,24,24,1536,128,128};
__device__ __constant__ int pw_off[PW_N] = {0,2048,6912,8448,106752,108288,206592,208128,209664,211200,212736,214272,224512,227072,227136,227200,227264,228800,228928};
constexpr size_t wsPW = wsEND;
constexpr size_t wsEND2 = wsPW + 229056ull * 4;
constexpr size_t wsCV = wsEND2;
#define PW(p, k) ((const float*)((p).ws + wsPW) + PWOFF_##k)
#define PWOFF_8 0
#define PWOFF_11 2048
#define PWOFF_12 6912
#define PWOFF_13 8448
#define PWOFF_14 106752
#define PWOFF_15 108288
#define PWOFF_16 206592
#define PWOFF_17 208128
#define PWOFF_18 209664
#define PWOFF_19 211200
#define PWOFF_20 212736
#define PWOFF_21 214272
#define PWOFF_22 224512
#define PWOFF_23 227072
#define PWOFF_24 227136
#define PWOFF_25 227200
#define PWOFF_26 227264
#define PWOFF_27 228800
#define PWOFF_28 228928

struct Params {
  const float* in[29];
  float* out;
  char* ws;
};

typedef __attribute__((ext_vector_type(2))) float f32x2_t;
typedef __attribute__((ext_vector_type(2))) __bf16 bf16x2_t;
DI u16 f2bf(float x) { return __builtin_bit_cast(u16, (__bf16)x); }
DI float bf2f(u16 v) { return __uint_as_float(((unsigned)v) << 16); }
DI unsigned pack2(float a, float b) { f32x2_t v = {a, b}; return __builtin_bit_cast(unsigned, __builtin_convertvector(v, bf16x2_t)); }
template <int CTRL> DI float dppf(float x) { return __int_as_float(__builtin_amdgcn_update_dpp(0, __float_as_int(x), CTRL, 0xF, 0xF, true)); }
template <int PAT> DI float swzf(float x) { return __int_as_float(__builtin_amdgcn_ds_swizzle(__float_as_int(x), PAT)); }
DI float bperm(float x, int srclane) { return __int_as_float(__builtin_amdgcn_ds_bpermute(srclane << 2, __float_as_int(x))); }
DI float sx1(float x) { return dppf<0xB1>(x); }
DI float sx2(float x) { return dppf<0x4E>(x); }
DI float sx4(float x) { return swzf<0x101F>(x); }
DI float sx8(float x) { return swzf<0x201F>(x); }
DI float sx16(float x) { return swzf<0x401F>(x); }
DI float red16(float v) { v += dppf<0x128>(v); v += dppf<0x124>(v); v += dppf<0x122>(v); v += dppf<0x121>(v); return v; }
DI float wave_sum(float v, int lane) {
  v = red16(v); v += sx16(v); v += bperm(v, lane ^ 32);
  return v;
}
DI float frcp(float x) { return __builtin_amdgcn_rcpf(x); }
DI float silu(float x) { return x * frcp(1.f + __expf(-x)); }
DI float softplusf(float x) { return fmaxf(x, 0.f) + __logf(1.f + __expf(-fabsf(x))); }
DI float dpp_xor1(float x) { return __int_as_float(__builtin_amdgcn_update_dpp(0, __float_as_int(x), 0xB1, 0xF, 0xF, true)); }
DI float dpp_xor2(float x) { return __int_as_float(__builtin_amdgcn_update_dpp(0, __float_as_int(x), 0x4E, 0xF, 0xF, true)); }
DI bf16x8 ldfrag(const u16* base, int ld, int row, int k) {
  return *(const bf16x8*)(base + row * ld + k);
}
DI unsigned uidx(long row, int col) { return ((unsigned)(col >> 6) * (unsigned)MT + (unsigned)row) * 64u + (unsigned)(col & 63); }
DI Params launder_params(const Params& p) {
  Params q = p;
  asm volatile("" : "+s"(q.ws), "+s"(q.out), "+s"(q.in[2]), "+s"(q.in[3]), "+s"(q.in[4]), "+s"(q.in[5]), "+s"(q.in[6]), "+s"(q.in[7]));
  return q;
}
DI int opaque_tid(int wv) { int t = wv * 64 + (int)__builtin_amdgcn_mbcnt_hi(~0u, __builtin_amdgcn_mbcnt_lo(~0u, 0u)); asm volatile("" : "+v"(t)); return t; }
#define MFMA16(a, b, c) __builtin_amdgcn_mfma_f32_16x16x32_bf16((a), (b), (c), 0, 0, 0)

DI const float* xrow(const Params& p, int layer, long row) {
  if (layer == 0) return row < MP ? p.in[0] + row * DM : p.in[1] + (row - MP) * DM;
  return p.out + row * DM;
}
DI int src_col(int n) {
  if (n < 768) return O1 + n;
  if (n < 1536) return O2 + (n - 768);
  if (n < 2048) return O8 + (n - 1536);
  if (n < 4480) return n - 2048;
  if (n < 5760) return O3 + (n - 4480);
  if (n < 6272) return O5 + (n - 5760);
  if (n < 6284) return O4 + (n - 6272);
  if (n < 6400) return -1;
  if (n < 6912) return O6 + (n - 6400);
  return O7 + (n - 6912);
}

DI void phase_wprep(int wv, const Params& p, char* smc) {
  const int otid = opaque_tid(wv);
  for (int a = 0; a < PW_N; ++a) {
    const float* src = p.in[pw_idx[a]];
    float* dst = (float*)(p.ws + wsPW) + pw_off[a];
    for (int i = blockIdx.x * 256 + otid; i < pw_size[a]; i += gridDim.x * 256) dst[i] = src[i];
  }
  float* T = (float*)smc;
  const int tid = otid;
  const int nWin = (NP / 64) * 16, nWout = 32 * 16;
  const int total = 2 * (nWin + nWout);
  for (int t = blockIdx.x; t < total; t += gridDim.x) {
    int layer = t / (nWin + nWout), r = t % (nWin + nWout);
    __syncthreads();
    if (r < nWin) {
      int n0 = (r / 16) * 64, k0 = (r % 16) * 64;
      const float* W = p.in[9] + (size_t)layer * DM * NIN;
      const float* nw = p.in[8] + layer * DM;
      int nn = tid & 63, sc = src_col(n0 + nn);
      for (int kk = tid >> 6; kk < 64; kk += 4)
        T[kk * 65 + nn] = sc >= 0 ? W[(size_t)(k0 + kk) * NIN + sc] * nw[k0 + kk] : 0.f;
      __syncthreads();
      u16* D = (u16*)(p.ws + wsWIN) + (size_t)layer * NP * 1024;
      int kk = tid & 63;
      for (int n2 = tid >> 6; n2 < 64; n2 += 4) D[(size_t)(n0 + n2) * 1024 + k0 + kk] = f2bf(T[kk * 65 + n2]);
    } else {
      r -= nWin;
      int k0 = (r / 16) * 64, n0 = (r % 16) * 64;
      const float* W = p.in[10] + (size_t)layer * 2048 * 1024;
      const float* snw = p.in[26] + layer * DB;
      int nn = tid & 63;
      for (int kk = tid >> 6; kk < 64; kk += 4) {
        int k = k0 + kk;
        float s = (k >= 768 && k < 1536) ? snw[k - 768] : 1.f;
        T[kk * 65 + nn] = W[(size_t)k * 1024 + n0 + nn] * s;
      }
      __syncthreads();
      u16* D = (u16*)(p.ws + wsWOUT) + (size_t)layer * 1024 * 2048;
      int kk = tid & 63;
      for (int n2 = tid >> 6; n2 < 64; n2 += 4) D[(size_t)(n0 + n2) * 2048 + k0 + kk] = f2bf(T[kk * 65 + n2]);
    }
  }
}

DI void phase_norm(int wv, const Params& p, int layer) {
  const int otid = opaque_tid(wv);
  const int wave = otid >> 6, lane = otid & 63;
  u16* XN = (u16*)(p.ws + wsXN);
  for (long row = blockIdx.x * 4 + wave; row < MT; row += gridDim.x * 4) {
    const float4* x = (const float4*)xrow(p, layer, row);
    float4 v[4];
    float ss = 0.f;
#pragma unroll
    for (int i = 0; i < 4; ++i) {
      v[i] = x[lane + 64 * i];
      ss += v[i].x * v[i].x + v[i].y * v[i].y + v[i].z * v[i].z + v[i].w * v[i].w;
    }
    ss = wave_sum(ss, lane);
    float rs = rsqrtf(ss * (1.f / 1024.f) + 1e-6f);
    u32x2* o = (u32x2*)(XN + row * 1024);
#pragma unroll
    for (int i = 0; i < 4; ++i) {
      u32x2 w;
      w[0] = pack2(v[i].x * rs, v[i].y * rs);
      w[1] = pack2(v[i].z * rs, v[i].w * rs);
      o[lane + 64 * i] = w;
    }
  }
  float* ssq = (float*)(p.ws + wsSSQ);
  for (long i = (long)blockIdx.x * 256 + otid; i < (long)MT * 2; i += (long)gridDim.x * 256) ssq[i] = 0.f;
  if (blockIdx.x == 0 && otid == 0) { ((int*)(p.ws + wsCNT))[layer] = 0; ((int*)(p.ws + wsCNT))[layer + 2] = 0; }
  if (blockIdx.x == 0 && otid < 48) ((int*)(p.ws + wsCV))[layer * 48 + otid] = 0;
}

DI int swz(int row, int c) { return row * 128 + ((c ^ ((row >> 1) & 7)) << 4); }

DI void gemm_mainloop(int wv, const u16* __restrict__ A, long lda, long a_kstep, const u16* __restrict__ Bt, long ldb, int K,
                      char* smc, f32x4 (&acc)[4][4], const bool seg = false, const float* sc0 = nullptr, const float* sc1 = nullptr) {
  const int otid = opaque_tid(wv);
  const int tid = otid, lane = tid & 63, wave = tid >> 6, wm = wave >> 1, wn = wave & 1;
  char* As = smc;
  char* Bs = smc + 32768;
#pragma unroll
  for (int i = 0; i < 4; ++i)
#pragma unroll
    for (int j = 0; j < 4; ++j) acc[i][j] = f32x4{0.f, 0.f, 0.f, 0.f};
  u32x4 ra[4], rb[4], ra2[4], rb2[4];
  const int lr = tid >> 3, lc = tid & 7;
  const u16* ag = A + (long)lr * lda + lc * 8;
  const u16* bg = Bt + (long)lr * ldb + lc * 8;
  const int nk = K / 64;
#pragma unroll
  for (int i = 0; i < 4; ++i) {
    ra[i] = *(const u32x4*)(ag + (long)(32 * i) * lda);
    rb[i] = *(const u32x4*)(bg + (long)(32 * i) * ldb);
  }
#pragma unroll
  for (int i = 0; i < 4; ++i) {
    ra2[i] = *(const u32x4*)(ag + (long)(32 * i) * lda + a_kstep);
    rb2[i] = *(const u32x4*)(bg + (long)(32 * i) * ldb + 64);
  }
  __syncthreads();
#pragma unroll
  for (int i = 0; i < 4; ++i) {
    *(u32x4*)(As + swz(lr + 32 * i, lc)) = ra[i];
    *(u32x4*)(Bs + swz(lr + 32 * i, lc)) = rb[i];
  }
  __syncthreads();
  const int fr = lane & 15, fq = lane >> 4;
#define GEMM_STEP(kt, cur, fa, fb, wa, wb)                                                                       \
  {                                                                                                              \
    {     \
      const int kf = min((kt) + 2, nk - 1);                                                                      \
      _Pragma("unroll") for (int i = 0; i < 4; ++i) {                                                            \
        fa[i] = *(const u32x4*)(ag + (long)(32 * i) * lda + (long)kf * a_kstep);                                 \
        fb[i] = *(const u32x4*)(bg + (long)(32 * i) * ldb + kf * 64);                                            \
      }                                                                                                          \
    }                                                                                                            \
    const char* as = As + (cur) * 16384;                                                                         \
    const char* bs = Bs + (cur) * 16384;                                                                         \
    _Pragma("unroll") for (int ks = 0; ks < 2; ++ks) {                                                           \
      bf16x8 af[4], bfr[4];                                                                                      \
      _Pragma("unroll") for (int i = 0; i < 4; ++i) {                                                            \
        af[i] = *(const bf16x8*)(as + swz(wm * 64 + i * 16 + fr, ks * 4 + fq));                                  \
        bfr[i] = *(const bf16x8*)(bs + swz(wn * 64 + i * 16 + fr, ks * 4 + fq));                                 \
      }                                                                                                          \
      _Pragma("unroll") for (int i = 0; i < 4; ++i)                                                              \
        _Pragma("unroll") for (int j = 0; j < 4; ++j) acc[i][j] = MFMA16(bfr[j], af[i], acc[i][j]);              \
    }                                                                                                            \
    if ((kt) + 1 < nk) {                                                                                         \
      char* an = As + ((cur) ^ 1) * 16384;                                                                       \
      char* bn = Bs + ((cur) ^ 1) * 16384;                                                                       \
      _Pragma("unroll") for (int i = 0; i < 4; ++i) {                                                            \
        *(u32x4*)(an + swz(lr + 32 * i, lc)) = wa[i];                                                            \
        *(u32x4*)(bn + swz(lr + 32 * i, lc)) = wb[i];                                                            \
      }                                                                                                          \
    }                                                                                                            \
    __syncthreads();                                                                                             \
  }
  for (int kt = 0; kt < nk; kt += 2) {
    if (seg && (kt == 12 || kt == 18 || kt == 24)) {
#pragma unroll
      for (int i = 0; i < 4; ++i) {
        const float f = kt == 12 ? 1.f / sc0[i] : (kt == 18 ? sc0[i] / sc1[i] : sc1[i]);
#pragma unroll
        for (int j = 0; j < 4; ++j)
#pragma unroll
          for (int e = 0; e < 4; ++e) acc[i][j][e] *= f;
      }
    }
    GEMM_STEP(kt, 0, ra, rb, ra2, rb2)
    GEMM_STEP(kt + 1, 1, ra2, rb2, ra, rb)
  }
#undef GEMM_STEP
}

DI void phase_inproj(int wv, const Params& p, int layer, char* smc) {
  const int otid = opaque_tid(wv);
  const u16* XN = (const u16*)(p.ws + wsXN);
  const u16* W = (const u16*)(p.ws + wsWIN) + (size_t)layer * NP * 1024;
  u16* U = (u16*)(p.ws + wsU);
  const int lane = otid & 63, wave = otid >> 6, wm = wave >> 1, wn = wave & 1;
  const int fr = lane & 15, fq = lane >> 4;
  const int NTN = NP / 128, NTM = MT / 128;
  const int xcd = blockIdx.x & 7, slot = blockIdx.x >> 3, nslots = gridDim.x >> 3;
  constexpr int PER_XCD = (NTN * NTM) / 8;
  constexpr int FULLG = 7 * 8 * NTM;
  for (int tq = slot; tq < PER_XCD; tq += nslots) {
    const int q = xcd * PER_XCD + tq;
    int tn, tm;
    if (q < FULLG) { const int g8 = q / (8 * NTM), r = q % (8 * NTM); tm = r >> 3; tn = 8 * g8 + (r & 7); }
    else { const int r = q - FULLG; tm = r >> 1; tn = 56 + (r & 1); }
    f32x4 acc[4][4];
    gemm_mainloop(wv, XN + (size_t)tm * 128 * 1024, 1024, 64, W + (size_t)tn * 128 * 1024, 1024, 1024, smc, acc);
    const int colbase = tn * 128 + wn * 64;
    const bool isq = colbase >= cQ && colbase < cDT;
    const bool isk = colbase >= cK && colbase < cV;
    if (isq || isk) {
      const float* nw = isq ? PW(p, 27) + layer * 64 : PW(p, 28) + layer * 64;
      const float sc = isq ? 0.125f : 1.f;
      float nwr[4][4];
#pragma unroll
      for (int n = 0; n < 4; ++n)
#pragma unroll
        for (int jj = 0; jj < 4; ++jj) nwr[n][jj] = nw[n * 16 + 4 * fq + jj] * sc;
#pragma unroll
      for (int i = 0; i < 4; ++i) {
        float ss = 0.f;
#pragma unroll
        for (int n = 0; n < 4; ++n)
#pragma unroll
          for (int jj = 0; jj < 4; ++jj) ss += acc[i][n][jj] * acc[i][n][jj];
        ss += sx16(ss);
        ss += bperm(ss, lane ^ 32);
        const float rs = rsqrtf(ss * (1.f / 64.f) + 1e-6f);
#pragma unroll
        for (int n = 0; n < 4; ++n)
#pragma unroll
          for (int jj = 0; jj < 4; ++jj) acc[i][n][jj] *= rs * nwr[n][jj];
      }
    }
    if (colbase < NU) {
      u16* blk = U + (size_t)(colbase >> 6) * MT * 64 + ((size_t)tm * 128 + wm * 64) * 64;
      u16* R = (u16*)smc + wave * (64 * 72);
#pragma unroll
      for (int i = 0; i < 4; ++i)
#pragma unroll
        for (int n = 0; n < 4; ++n) {
          u32x2 pk;
          pk[0] = pack2(acc[i][n][0], acc[i][n][1]);
          pk[1] = pack2(acc[i][n][2], acc[i][n][3]);
          *(u32x2*)(R + (i * 16 + fr) * 72 + n * 16 + 4 * fq) = pk;
        }
#pragma unroll
      for (int k = 0; k < 8; ++k) {
        const int id = lane + 64 * k, r = id >> 3, c = id & 7;
        __builtin_nontemporal_store(*(const u32x4*)(R + r * 72 + c * 8), (u32x4*)(blk + r * 64 + c * 8));
      }
    } else {
      const bool kk = colbase < cV;
      const int head = (colbase - (kk ? cK : cV)) >> 6;
#pragma unroll
      for (int i = 0; i < 4; ++i) {
        const long row = (long)tm * 128 + wm * 64 + i * 16 + fr;
        float* dst;
        if (row < MP) {
          long b = row >> 12, tt = row & 4095;
          dst = p.out + (kk ? oPK : oPV) + ((((long)layer * NB + b) * HC + head) * SEQ + tt) * 64;
        } else {
          long r2 = row - MP, b = r2 >> 4, tt = r2 & 15;
          dst = p.out + (kk ? oSK : oSV) + ((((long)layer * NSB + b) * HC + head) * SSEQ + tt) * 64;
        }
#pragma unroll
        for (int n = 0; n < 4; ++n)
          *(float4*)(dst + n * 16 + 4 * fq) = float4{acc[i][n][0], acc[i][n][1], acc[i][n][2], acc[i][n][3]};
      }
    }
  }
}

DI void phase_outproj(int wv, const Params& p, int layer, char* smc) {
  const int otid = opaque_tid(wv);
  const u16* U = (const u16*)(p.ws + wsU);
  const u16* W = (const u16*)(p.ws + wsWOUT) + (size_t)layer * 1024 * 2048;
  const int lane = otid & 63, wave = otid >> 6, wm = wave >> 1, wn = wave & 1;
  const int fr = lane & 15, fq = lane >> 4;
  const int NTN = 8, NTM = MT / 128;
  const int xcd = blockIdx.x & 7, slot = blockIdx.x >> 3, nslots = gridDim.x >> 3;
  const int nmt = (NTM - xcd + 7) >> 3;
  for (int tl = slot; tl < nmt * NTN; tl += nslots) {
    const int tn = tl % NTN, tm = (tl / NTN) * 8 + xcd;
    f32x4 acc[4][4];
    float sc0[4], sc1[4];
    {
      const float* SSQ = (const float*)(p.ws + wsSSQ);
#pragma unroll
      for (int i = 0; i < 4; ++i) {
        const long row = (long)tm * 128 + wm * 64 + i * 16 + fr;
        sc0[i] = rsqrtf(SSQ[row * 2 + 0] * (1.f / 384.f) + 1e-5f);
        sc1[i] = rsqrtf(SSQ[row * 2 + 1] * (1.f / 384.f) + 1e-5f);
      }
    }
    gemm_mainloop(wv, U + (size_t)tm * 128 * 64, 64, (long)MT * 64, W + (size_t)tn * 128 * 2048, 2048, 2048, smc, acc, true, sc0, sc1);
#pragma unroll
    for (int i = 0; i < 4; ++i) {
      const long row = (long)tm * 128 + wm * 64 + i * 16 + fr;
      const float* xi = xrow(p, layer, row);
      float* yo = p.out + row * DM;
#pragma unroll
      for (int n = 0; n < 4; ++n) {
        const int col = tn * 128 + wn * 64 + n * 16 + 4 * fq;
        const f32x4 x4 = __builtin_nontemporal_load((const f32x4*)(xi + col));
        __builtin_nontemporal_store(x4 + acc[i][n], (f32x4*)(yo + col));
      }
    }
  }
}

DI void rwkv_item(int wv, const Params& p, int layer, int b, int h, bool samp, char* smc, bool dry) {
  const int otid = opaque_tid(wv);
  const int tid = otid, lane = tid & 63, w = tid >> 6, fr = lane & 15, fq = lane >> 4;
  const int lt = tid >> 4, lp = tid & 15;
  const int T = samp ? SSEQ : SEQ;
  const long row0 = samp ? (long)MP + b * SSEQ : (long)b * SEQ;
  u16* U = (u16*)(p.ws + wsU);
  float* CL = (float*)smc;
  float* AabF = CL + 2048;
  float* PC = AabF + 512;
  float* RKD = PC + 128;
  u16* ASb = (u16*)(RKD + 32);
  u16* OPA = ASb + 32 * 64;
  u16* OPR = OPA + 32 * 72;
  u16* OPK = OPR + 32 * 72;
  u16* OPB = OPK + 32 * 72;
  u16* VT = OPB + 32 * 72;
  u16* UT = VT + 64 * 40 + 64;
  u16* Sb = UT + 64 * 40;
  u16* Aak = Sb + 64 * 72;
  u16* Ark = Aak + 2 * 16 * 40;
  u16* Arb = Ark + 2 * 16 * 40;
  float* YY = CL;
  u16* TWb = OPK;
  u16* TAb = OPB;
  const float* mu = PW(p, 11) + layer * WSH;
  const float* w2 = PW(p, 13) + (size_t)layer * 64 * DA + h * 64;
  const float* a2 = PW(p, 15) + (size_t)layer * 64 * DA + h * 64;
  const float* shift0 = p.in[3] + ((size_t)layer * NSB + b) * WSH;
  const int hc = layer * DA + h * 64;
  int oc[5];
  float muc[5][4];
#pragma unroll
  for (int seg = 0; seg < 5; ++seg) {
    oc[seg] = (seg < 3 ? seg * 768 + h * 64 : (seg == 3 ? 2304 : 2368)) + 4 * lp;
#pragma unroll
    for (int e = 0; e < 4; ++e) muc[seg][e] = mu[oc[seg] + e];
  }
  float kkc[4], kac[4], rkc[4], lnw[4], lnb[4];
#pragma unroll
  for (int e = 0; e < 4; ++e) {
    kkc[e] = PW(p, 16)[hc + 4 * lp + e];
    kac[e] = PW(p, 17)[hc + 4 * lp + e];
    rkc[e] = PW(p, 18)[hc + 4 * lp + e];
    lnw[e] = PW(p, 19)[hc + 4 * lp + e];
    lnb[e] = PW(p, 20)[hc + 4 * lp + e];
  }
  const float w0c = PW(p, 12)[hc + 16 * w + fr], a0c = PW(p, 14)[hc + 16 * w + fr];
  bf16x8 bw[2], ba[2];
#pragma unroll
  for (int ks = 0; ks < 2; ++ks)
#pragma unroll
    for (int e = 0; e < 8; ++e) {
      const int j = 32 * ks + 8 * fq + e;
      bw[ks][e] = (short)f2bf(w2[(size_t)j * DA + 16 * w + fr]);
      ba[ks][e] = (short)f2bf(a2[(size_t)j * DA + 16 * w + fr]);
    }
  f32x4 Sacc[4];
  __syncthreads();
  {
    const float* s0 = p.in[2] + (((size_t)layer * NSB + b) * HA + h) * 4096;
#pragma unroll
    for (int nt = 0; nt < 4; ++nt)
#pragma unroll
      for (int jj = 0; jj < 4; ++jj) {
        const int i = 16 * w + 4 * fq + jj, j = 16 * nt + fr;
        float v = samp ? s0[i * 64 + j] : 0.f;
        Sacc[nt][jj] = v;
        Sb[i * 72 + j] = f2bf(v);
      }
    for (int id = tid; id < (2 * 64 * 40 + 64) / 2; id += 256) ((unsigned*)VT)[id] = 0u;
    for (int id = tid; id < (3 * 2 * 16 * 40) / 2; id += 256) ((unsigned*)Aak)[id] = 0u;
  }
  u32x2 cu[2][5], pu[2][5], gq[2];
  auto issue_loads = [&](int t0) {
#pragma unroll
    for (int u = 0; u < 2; ++u) {
      const int tt = min(t0 + lt + 16 * u, T - 1);
      const long row = row0 + tt;
#pragma unroll
      for (int seg = 0; seg < 5; ++seg) {
        cu[u][seg] = *(const u32x2*)(U + uidx(row, cUA + oc[seg]));
        pu[u][seg] = *(const u32x2*)(U + uidx(tt > 0 ? row - 1 : row, cUA + oc[seg]));
      }
      gq[u] = *(const u32x2*)(U + uidx(row, cGA + h * 64 + 4 * lp));
    }
  };
  issue_loads(0);
  for (int t0 = 0; t0 < T; t0 += 32) {
    int fr_l = fr, fq_l = fq, lt_l = lt, lp_l = lp, w_l = w;
    asm volatile("" : "+v"(fr_l), "+v"(fq_l), "+v"(lt_l), "+v"(lp_l), "+v"(w_l));
    const int fr = fr_l, fq = fq_l, lt = lt_l, lp = lp_l, w = w_l;
    const int nsub = (T - t0) >= 32 ? 2 : 1;
    float rkv[2][3][4];
#pragma unroll
    for (int u = 0; u < 2; ++u) {
      const int tok = lt + 16 * u;
#pragma unroll
      for (int seg = 0; seg < 5; ++seg) {
        float c[4], pv[4], o[4];
        c[0] = __uint_as_float(cu[u][seg][0] << 16); c[1] = __uint_as_float(cu[u][seg][0] & 0xffff0000u);
        c[2] = __uint_as_float(cu[u][seg][1] << 16); c[3] = __uint_as_float(cu[u][seg][1] & 0xffff0000u);
        pv[0] = __uint_as_float(pu[u][seg][0] << 16); pv[1] = __uint_as_float(pu[u][seg][0] & 0xffff0000u);
        pv[2] = __uint_as_float(pu[u][seg][1] << 16); pv[3] = __uint_as_float(pu[u][seg][1] & 0xffff0000u);
        if (t0 + tok == 0) {
#pragma unroll
          for (int e = 0; e < 4; ++e) pv[e] = samp ? shift0[oc[seg] + e] : 0.f;
        }
#pragma unroll
        for (int e = 0; e < 4; ++e) o[e] = c[e] + (pv[e] - c[e]) * muc[seg][e];
        if (seg < 3) {
#pragma unroll
          for (int e = 0; e < 4; ++e) rkv[u][seg][e] = o[e];
        } else {
          if (seg == 3) {
#pragma unroll
            for (int e = 0; e < 4; ++e) o[e] = 1.f - 2.f * frcp(1.f + __expf(2.f * o[e]));
          }
          u32x2 pk;
          pk[0] = pack2(o[0], o[1]);
          pk[1] = pack2(o[2], o[3]);
          *(u32x2*)&(seg == 3 ? TWb : TAb)[tok * 72 + 4 * lp] = pk;
        }
      }
    }
    const u32x2 gate0 = gq[0], gate1 = gq[1];
    issue_loads(min(t0 + 32, T - 1));
    __syncthreads();
#pragma unroll
    for (int u = 0; u < 2; ++u) {
      f32x4 accw = {0.f, 0.f, 0.f, 0.f}, acca = {0.f, 0.f, 0.f, 0.f};
#pragma unroll
      for (int ks = 0; ks < 2; ++ks) {
        accw = MFMA16(ldfrag(TWb, 72, 16 * u + fr, 32 * ks + 8 * fq), bw[ks], accw);
        acca = MFMA16(ldfrag(TAb, 72, 16 * u + fr, 32 * ks + 8 * fq), ba[ks], acca);
      }
      float lw[4], pre[4];
#pragma unroll
      for (int jj = 0; jj < 4; ++jj) {
        float wl = w0c + accw[jj];
        float wlog = -softplusf(-wl) - 0.5f;
        lw[jj] = -__expf(wlog);
      }
      pre[0] = lw[0]; pre[1] = pre[0] + lw[1]; pre[2] = pre[1] + lw[2]; pre[3] = pre[2] + lw[3];
      const float tot = pre[3];
      const float t1 = bperm(tot, lane - 16), t2 = bperm(tot, lane - 32), t3 = bperm(tot, lane - 48);
      const float base = (fq >= 1 ? t1 : 0.f) + (fq >= 2 ? t2 : 0.f) + (fq >= 3 ? t3 : 0.f);
      const int c = 16 * w + fr;
#pragma unroll
      for (int jj = 0; jj < 4; ++jj) {
        const int t = 16 * u + 4 * fq + jj;
        CL[t * 64 + c] = base + pre[jj];
        ASb[t * 64 + c] = f2bf(frcp(1.f + __expf(-(a0c + acca[jj]))));
      }
      if (fq == 3) PC[u * 64 + c] = __expf(base + pre[3]);
    }
    __syncthreads();
#pragma unroll
    for (int u = 0; u < 2; ++u) {
      const int tok = lt + 16 * u;
      const float4 cl4 = *(const float4*)&CL[tok * 64 + 4 * lp];
      float4 cp4 = {0.f, 0.f, 0.f, 0.f};
      if (lt > 0) cp4 = *(const float4*)&CL[(tok - 1) * 64 + 4 * lp];
      const u32x2 as2 = *(const u32x2*)&ASb[tok * 64 + 4 * lp];
      const float av[4] = {__uint_as_float(as2[0] << 16), __uint_as_float(as2[0] & 0xffff0000u), __uint_as_float(as2[1] << 16),
                           __uint_as_float(as2[1] & 0xffff0000u)};
      const float clv[4] = {cl4.x, cl4.y, cl4.z, cl4.w}, cpv[4] = {cp4.x, cp4.y, cp4.z, cp4.w};
      float kk[4], ss = 0.f;
#pragma unroll
      for (int e = 0; e < 4; ++e) { kk[e] = rkv[u][1][e] * kkc[e]; ss += kk[e] * kk[e]; }
      ss = red16(ss);
      const float inv = fminf(__builtin_amdgcn_rsqf(ss), 1e12f);
      float rk = 0.f, oa[4], orr[4], ok[4], ob[4];
#pragma unroll
      for (int e = 0; e < 4; ++e) {
        const float kkn = kk[e] * inv;
        const float kn = rkv[u][1][e] * (1.f + (av[e] - 1.f) * kac[e]);
        rk += rkv[u][0][e] * kn * rkc[e];
        const float P = __expf(clv[e]), Pm1 = __expf(cpv[e]), Pinv = __expf(-clv[e]);
        oa[e] = -kkn * Pm1;
        orr[e] = rkv[u][0][e] * P;
        ok[e] = kn * Pinv;
        ob[e] = kkn * av[e] * Pinv;
        VT[(4 * lp + e) * 40 + (((4 * lp + e) >> 3) << 3) + tok] = f2bf(rkv[u][2][e]);
      }
      rk = red16(rk);
      if (lp == 0) RKD[tok] = rk;
      u32x2 pk;
      pk[0] = pack2(oa[0], oa[1]); pk[1] = pack2(oa[2], oa[3]);
      *(u32x2*)&OPA[tok * 72 + 4 * lp] = pk;
      pk[0] = pack2(orr[0], orr[1]); pk[1] = pack2(orr[2], orr[3]);
      *(u32x2*)&OPR[tok * 72 + 4 * lp] = pk;
      pk[0] = pack2(ok[0], ok[1]); pk[1] = pack2(ok[2], ok[3]);
      *(u32x2*)&OPK[tok * 72 + 4 * lp] = pk;
      pk[0] = pack2(ob[0], ob[1]); pk[1] = pack2(ob[2], ob[3]);
      *(u32x2*)&OPB[tok * 72 + 4 * lp] = pk;
    }
    __syncthreads();
#pragma unroll
    for (int u = 0; u < 2; ++u) {
      const u16* Mop = (w & 2) ? OPR : OPA;
      const u16* Nop = (w & 1) ? OPB : OPK;
      f32x4 g = {0.f, 0.f, 0.f, 0.f};
#pragma unroll
      for (int ks = 0; ks < 2; ++ks)
        g = MFMA16(ldfrag(Mop, 72, 16 * u + fr, 32 * ks + 8 * fq), ldfrag(Nop, 72, 16 * u + fr, 32 * ks + 8 * fq), g);
#pragma unroll
      for (int jj = 0; jj < 4; ++jj) {
        const int t = 4 * fq + jj, s = fr;
        const bool keep = (w & 2) ? (s <= t) : (s < t);
        const float val = keep ? g[jj] : 0.f;
        if (w == 1) AabF[u * 256 + t * 16 + s] = val;
        else (w == 0 ? Aak : (w == 2 ? Ark : Arb))[u * 640 + t * 40 + 16 * u + s] = f2bf(val);
      }
    }
    __syncthreads();
    for (int u = 0; u < nsub; ++u) {
      const int ib = 16 * w + fr;
      const u16* VTr = VT + ((ib >> 3) << 3);
      f32x4 x = {0.f, 0.f, 0.f, 0.f};
#pragma unroll
      for (int ks = 0; ks < 2; ++ks) x = MFMA16(ldfrag(OPA, 72, 16 * u + fr, 32 * ks + 8 * fq), ldfrag(Sb, 72, ib, 32 * ks + 8 * fq), x);
      x = MFMA16(ldfrag(Aak + u * 640, 40, fr, 8 * fq), ldfrag(VTr, 40, ib, 8 * fq), x);
      const float* Af = AabF + u * 256;
      float xv[4] = {x[0], x[1], x[2], x[3]};
      float4 dg[4];
#pragma unroll
      for (int jj = 0; jj < 4; ++jj) dg[jj] = *(const float4*)&Af[(4 * fq + jj) * 16 + 4 * fq];
#pragma unroll
      for (int g = 0; g < 4; ++g) {
        if (fq == g) {
          xv[1] += dg[1].x * xv[0];
          xv[2] += dg[2].x * xv[0] + dg[2].y * xv[1];
          xv[3] += dg[3].x * xv[0] + dg[3].y * xv[1] + dg[3].z * xv[2];
        }
        if (g < 3) {
          float ug[4];
#pragma unroll
          for (int e = 0; e < 4; ++e) ug[e] = bperm(xv[e], fr + 16 * g);
          if (fq > g) {
#pragma unroll
            for (int jj = 0; jj < 4; ++jj) {
              const float4 c4 = *(const float4*)&Af[(4 * fq + jj) * 16 + 4 * g];
              xv[jj] += c4.x * ug[0] + c4.y * ug[1] + c4.z * ug[2] + c4.w * ug[3];
            }
          }
        }
      }
      {
        u32x2 pk;
        pk[0] = pack2(xv[0], xv[1]);
        pk[1] = pack2(xv[2], xv[3]);
        *(u32x2*)&UT[ib * 40 + 16 * u + 4 * fq] = pk;
      }
      f32x4 y = {0.f, 0.f, 0.f, 0.f};
#pragma unroll
      for (int ks = 0; ks < 2; ++ks) y = MFMA16(ldfrag(OPR, 72, 16 * u + fr, 32 * ks + 8 * fq), ldfrag(Sb, 72, ib, 32 * ks + 8 * fq), y);
      y = MFMA16(ldfrag(Ark + u * 640, 40, fr, 8 * fq), ldfrag(VTr, 40, ib, 8 * fq), y);
      y = MFMA16(ldfrag(Arb + u * 640, 40, fr, 8 * fq), ldfrag(UT, 40, ib, 8 * fq), y);
#pragma unroll
      for (int jj = 0; jj < 4; ++jj) YY[(16 * u + 4 * fq + jj) * 64 + ib] = y[jj];
      const bf16x8 af = (fq < 2) ? ldfrag(VTr, 40, ib, 16 * u + 8 * fq) : ldfrag(UT, 40, ib, 16 * u + 8 * (fq - 2));
      const u16* src = (fq < 2) ? OPK : OPB;
      const int s0 = 16 * u + (fq & 1) * 8;
#pragma unroll
      for (int nt = 0; nt < 4; ++nt) {
        bf16x8 bfg;
#pragma unroll
        for (int e = 0; e < 8; ++e) bfg[e] = (short)src[(s0 + e) * 72 + 16 * nt + fr];
        Sacc[nt] = MFMA16(af, bfg, Sacc[nt]);
        const float pc = PC[u * 64 + 16 * nt + fr];
#pragma unroll
        for (int jj = 0; jj < 4; ++jj) {
          Sacc[nt][jj] *= pc;
          Sb[(16 * w + 4 * fq + jj) * 72 + 16 * nt + fr] = f2bf(Sacc[nt][jj]);
        }
      }
    }
    __syncthreads();
#pragma unroll
    for (int u = 0; u < 2; ++u) {
      const int tok = lt + 16 * u;
      const float4 y4 = *(const float4*)&YY[tok * 64 + 4 * lp];
      const float y[4] = {y4.x, y4.y, y4.z, y4.w};
      float s1 = y[0] + y[1] + y[2] + y[3];
      s1 = red16(s1);
      const float mean = s1 * (1.f / 64.f);
      float s2 = 0.f;
#pragma unroll
      for (int e = 0; e < 4; ++e) { const float d = y[e] - mean; s2 += d * d; }
      s2 = red16(s2);
      const float rstd = rsqrtf(s2 * (1.f / 64.f) + 64e-5f);
      const float rkd = RKD[tok];
      const u32x2 gate = u ? gate1 : gate0;
      const float g[4] = {__uint_as_float(gate[0] << 16), __uint_as_float(gate[0] & 0xffff0000u),
                          __uint_as_float(gate[1] << 16), __uint_as_float(gate[1] & 0xffff0000u)};
      float o[4];
#pragma unroll
      for (int e = 0; e < 4; ++e) o[e] = ((y[e] - mean) * rstd * lnw[e] + lnb[e] + rkd * rkv[u][2][e]) * silu(g[e]);
      u32x2 pk;
      pk[0] = pack2(o[0], o[1]);
      pk[1] = pack2(o[2], o[3]);
      if (!dry && u < nsub) *(u32x2*)(U + uidx(row0 + t0 + tok, cGA + h * 64 + 4 * lp)) = pk;
    }
    __syncthreads();
  }
  if (!dry) {
    float* so = p.out + (samp ? oSRW + (((size_t)layer * NSB + b) * HA + h) * 4096 : oPRW + (((size_t)layer * NB + b) * HA + h) * 4096);
#pragma unroll
    for (int nt = 0; nt < 4; ++nt)
#pragma unroll
      for (int jj = 0; jj < 4; ++jj) so[(16 * w + 4 * fq + jj) * 64 + 16 * nt + fr] = Sacc[nt][jj];
    float* sh = p.out + (samp ? oSSH + ((size_t)layer * NSB + b) * WSH : oPSH + ((size_t)layer * NB + b) * WSH);
    if (tid < 192) {
      int col = (tid >> 6) * 768 + h * 64 + (tid & 63);
      sh[col] = bf2f(U[uidx(row0 + T - 1, cUA + col)]);
    }
    if (h == 0 && tid < 128) sh[2304 + tid] = bf2f(U[uidx(row0 + T - 1, cUA + 2304 + tid)]);
  }
}

DI void conv_item(int wv, const Params& p, int layer, int it) {
  const int otid = opaque_tid(wv);
  const int tid = otid;
  u16* U = (u16*)(p.ws + wsU);
  const int c8 = tid & 7, run = tid >> 3;
  {
    const bool samp = it >= NB * 20;
    const int ii = samp ? it - NB * 20 : it;
    const int b = ii / 20, cb = ii % 20;
    const int T = samp ? SSEQ : SEQ;
    const int RL = samp ? 1 : 128;
    const bool active = samp ? (run < 16) : true;
    const long row0 = samp ? (long)MP + b * SSEQ : (long)b * SEQ;
    const int chan = cb * 64 + c8 * 8;
    const float* cw = PW(p, 21) + (size_t)layer * 4 * CD + chan;
    const float* cbp = PW(p, 22) + layer * CD + chan;
    const float* conv0 = p.in[5] + ((size_t)layer * NSB + b) * 3 * CD + chan;
    float* co = p.out + (samp ? oSCV + ((size_t)layer * NSB + b) * 3 * CD : oPCV + ((size_t)layer * NB + b) * 3 * CD) + chan;
    float cwr[4][8], cbr[8];
#pragma unroll
    for (int e = 0; e < 8; ++e) {
      cbr[e] = cbp[e];
#pragma unroll
      for (int i = 0; i < 4; ++i) cwr[i][e] = cw[i * CD + e];
    }
    const int tstart = run * RL;
    u16* colp = U + uidx(row0, cXBC + chan);
    u32x4 w0 = {0u, 0u, 0u, 0u}, w1 = w0, w2 = w0;
    if (active) {
      if (tstart >= 3) {
        w0 = *(const u32x4*)(colp + (long)(tstart - 3) * 64);
        w1 = *(const u32x4*)(colp + (long)(tstart - 2) * 64);
        w2 = *(const u32x4*)(colp + (long)(tstart - 1) * 64);
      } else if (samp) {
#pragma unroll
        for (int i = 0; i < 3; ++i) {
          const int tt = tstart - 3 + i;
          u32x4 v;
          if (tt >= 0) v = *(const u32x4*)(colp + (long)tt * 64);
          else {
#pragma unroll
            for (int e = 0; e < 4; ++e) v[e] = pack2(conv0[(tt + 3) * CD + 2 * e], conv0[(tt + 3) * CD + 2 * e + 1]);
          }
          if (i == 0) w0 = v; else if (i == 1) w1 = v; else w2 = v;
        }
      }
    }
    __syncthreads();
    if (active) {
      for (int tb = tstart; tb < tstart + RL; tb += 4) {
        u32x4 wn[4];
#pragma unroll
        for (int u = 0; u < 4; ++u)
          if (tb + u < tstart + RL) wn[u] = *(const u32x4*)(colp + (long)(tb + u) * 64);
#pragma unroll
        for (int u = 0; u < 4; ++u) {
          const int t = tb + u;
          if (t < tstart + RL) {
            const u32x4 w3 = wn[u];
        float val[8];
#pragma unroll
            for (int e = 0; e < 4; ++e) {
              val[2 * e] = cbr[2 * e] + cwr[0][2 * e] * __uint_as_float(w0[e] << 16) + cwr[1][2 * e] * __uint_as_float(w1[e] << 16) +
                           cwr[2][2 * e] * __uint_as_float(w2[e] << 16) + cwr[3][2 * e] * __uint_as_float(w3[e] << 16);
              val[2 * e + 1] = cbr[2 * e + 1] + cwr[0][2 * e + 1] * __uint_as_float(w0[e] & 0xffff0000u) +
                               cwr[1][2 * e + 1] * __uint_as_float(w1[e] & 0xffff0000u) + cwr[2][2 * e + 1] * __uint_as_float(w2[e] & 0xffff0000u) +
                               cwr[3][2 * e + 1] * __uint_as_float(w3[e] & 0xffff0000u);
            }
            u32x4 pk;
#pragma unroll
            for (int e = 0; e < 4; ++e) pk[e] = pack2(silu(val[2 * e]), silu(val[2 * e + 1]));
            *(u32x4*)(colp + (long)t * 64) = pk;
            if (t >= T - 3) {
              float* d = co + (t - (T - 3)) * CD;
#pragma unroll
              for (int e = 0; e < 4; ++e) {
                d[2 * e] = __uint_as_float(w3[e] << 16);
                d[2 * e + 1] = __uint_as_float(w3[e] & 0xffff0000u);
              }
            }
            w0 = w1; w1 = w2; w2 = w3;
          }
        }
      }
    }
    __threadfence();
    __syncthreads();
    if (tid == 0) atomicAdd((int*)(p.ws + wsCV) + layer * 48 + (samp ? 16 + b : b), 1);
  }
}

DI void mamba_item(int wv, const Params& p, int layer, int b, int h, bool samp, char* smc, bool dry) {
  const int otid = opaque_tid(wv);
  const int tid = otid, lane = tid & 63, wave = tid >> 6, fr = lane & 15, fq = lane >> 4;
  const int T = samp ? SSEQ : SEQ;
  const long row0 = samp ? (long)MP + b * SSEQ : (long)b * SEQ;
  const int g = h / HPG;
  u16* U = (u16*)(p.ws + wsU);
  float* SSQ = (float*)(p.ws + wsSSQ);
  u16* Cm = (u16*)smc;
  u16* Bm = Cm + 32 * 136;
  u16* Xd = Bm + 32 * 136;
  u16* Xe = Xd + 32 * 72;
  u16* Mx = Xe + 32 * 72;
  u16* Sb = Mx + 32 * 40;
  u16* Zs = Sb + 64 * 136;
  float* fdt = (float*)(Zs + 32 * 72);
  float* fac = fdt + 32;
  float* fde = fac + 32;
  const float dtb = PW(p, 23)[layer * HB + h];
  const float Aneg = -__expf(PW(p, 24)[layer * HB + h]);
  const float Dh = PW(p, 25)[layer * HB + h];
  const int zt = tid >> 3, zc = (tid & 7) * 8;
  const int br = tid >> 4, bc = (tid & 15) * 8;
  const u16* xsp = U + uidx(row0, cXBC + h * 64 + zc);
  const u16* zp = U + uidx(row0, cZB + h * 64 + zc);
  const u16* bp0 = U + uidx(row0, cXBC + 768 + g * 128 + bc);
  const u16* cp0 = U + uidx(row0, cXBC + 1024 + g * 128 + bc);
  const u16* dtp = U + uidx(row0, cDT + h);
  f32x4 Sacc[8];
  __syncthreads();
  {
    const float* s0 = p.in[4] + (((size_t)layer * NSB + b) * HB + h) * 64 * DS;
#pragma unroll
    for (int nt = 0; nt < 8; ++nt)
#pragma unroll
      for (int j = 0; j < 4; ++j) {
        int pp = 16 * wave + 4 * fq + j, n = 16 * nt + fr;
        float v = samp ? s0[pp * DS + n] : 0.f;
        Sacc[nt][j] = v;
        Sb[pp * 136 + n] = f2bf(v);
      }
  }
  u32x4 xr, zr, br0, br1, cr0, cr1;
  float dtr = 0.f;
  auto issue = [&](int t0) {
    const u32x4 z4 = {0u, 0u, 0u, 0u};
    xr = zr = br0 = br1 = cr0 = cr1 = z4;
    if (t0 + zt < T) {
      xr = *(const u32x4*)(xsp + (long)(t0 + zt) * 64);
      zr = *(const u32x4*)(zp + (long)(t0 + zt) * 64);
    }
    if (t0 + br < T) {
      br0 = *(const u32x4*)(bp0 + (long)(t0 + br) * 64);
      cr0 = *(const u32x4*)(cp0 + (long)(t0 + br) * 64);
    }
    if (t0 + br + 16 < T) {
      br1 = *(const u32x4*)(bp0 + (long)(t0 + br + 16) * 64);
      cr1 = *(const u32x4*)(cp0 + (long)(t0 + br + 16) * 64);
    }
    if (tid < 32) dtr = (t0 + tid < T) ? bf2f(dtp[(long)(t0 + tid) * 64]) : 0.f;
  };
  if (tid == 0) {
    const int* cvp = (const int*)(p.ws + wsCV) + layer * 48 + (samp ? 16 + b : b);
    while (__hip_atomic_load(cvp, __ATOMIC_RELAXED, __HIP_MEMORY_SCOPE_AGENT) < 20) __builtin_amdgcn_s_sleep(16);
  }
  __syncthreads();
  __threadfence();
  issue(0);
  for (int t0 = 0; t0 < T; t0 += 32) {
    const int nv = min(32, T - t0);
    if (tid < 32) {
      const int t = tid;
      float dt = (t < nv) ? softplusf(dtr + dtb) : 0.f;
      float a = dt * Aneg;
#pragma unroll
      for (int o = 1; o < 32; o <<= 1) {
        float v = bperm(a, t - o);
        if (t >= o) a += v;
      }
      float last = bperm(a, 31);
      fdt[t] = dt; fac[t] = a; fde[t] = __expf(last - a);
    }
    *(u32x4*)&Bm[br * 136 + bc] = br0;
    *(u32x4*)&Bm[(br + 16) * 136 + bc] = br1;
    *(u32x4*)&Cm[br * 136 + bc] = cr0;
    *(u32x4*)&Cm[(br + 16) * 136 + bc] = cr1;
    *(u32x4*)&Zs[zt * 72 + zc] = zr;
    __syncthreads();
    {
      const float dt = fdt[zt], dde = dt * fde[zt];
      u32x4 pk, pe;
#pragma unroll
      for (int e = 0; e < 4; ++e) {
        const float lo = __uint_as_float(xr[e] << 16), hi = __uint_as_float(xr[e] & 0xffff0000u);
        pk[e] = pack2(lo * dt, hi * dt);
        pe[e] = pack2(lo * dde, hi * dde);
      }
      *(u32x4*)&Xd[zt * 72 + zc] = pk;
      *(u32x4*)&Xe[zt * 72 + zc] = pe;
    }
    {
      const int mq = wave >> 1, ns = wave & 1;
      f32x4 G = {0.f, 0.f, 0.f, 0.f};
#pragma unroll
      for (int ks = 0; ks < 4; ++ks)
        G = MFMA16(ldfrag(Cm, 136, 16 * mq + fr, 32 * ks + 8 * fq), ldfrag(Bm, 136, 16 * ns + fr, 32 * ks + 8 * fq), G);
#pragma unroll
      for (int j = 0; j < 4; ++j) {
        const int q = 16 * mq + 4 * fq + j, s = 16 * ns + fr;
        float m = (s <= q) ? G[j] * __expf(fac[q] - fac[s]) : 0.f;
        Mx[q * 40 + s] = f2bf(m);
      }
    }
    if (t0 + 32 < T) issue(t0 + 32);
    __syncthreads();
    {
      const int mq = wave >> 1;
      float ssq[4] = {0.f, 0.f, 0.f, 0.f};
#pragma unroll
      for (int pi = 0; pi < 2; ++pi) {
        const int pt = (wave & 1) * 2 + pi;
        f32x4 yd = {0.f, 0.f, 0.f, 0.f}, yo = {0.f, 0.f, 0.f, 0.f};
        {
          bf16x8 xg;
#pragma unroll
          for (int e = 0; e < 8; ++e) xg[e] = (short)Xd[(8 * fq + e) * 72 + 16 * pt + fr];
          yd = MFMA16(ldfrag(Mx, 40, 16 * mq + fr, 8 * fq), xg, yd);
        }
#pragma unroll
        for (int ks = 0; ks < 4; ++ks)
          yo = MFMA16(ldfrag(Cm, 136, 16 * mq + fr, 32 * ks + 8 * fq), ldfrag(Sb, 136, 16 * pt + fr, 32 * ks + 8 * fq), yo);
#pragma unroll
        for (int j = 0; j < 4; ++j) {
          const int q = 16 * mq + 4 * fq + j, pp = 16 * pt + fr;
          if (q < nv) {
            float y = yd[j] + __expf(fac[q]) * yo[j] + Dh * bf2f(Xd[q * 72 + pp]) * frcp(fdt[q]);
            float o = y * silu(bf2f(Zs[q * 72 + pp]));
            Zs[q * 72 + pp] = f2bf(o);
            ssq[j] += o * o;
          }
        }
      }
#pragma unroll
      for (int j = 0; j < 4; ++j) {
        float s = red16(ssq[j]);
        const int q = 16 * mq + 4 * fq + j;
        if (!dry && fr == 0 && q < nv) atomicAdd(&SSQ[(row0 + t0 + q) * 2 + g], s);
      }
    }
    {
      const float cd = __expf(fac[31]);
      bf16x8 a;
#pragma unroll
      for (int e = 0; e < 8; ++e) a[e] = (short)Xe[(8 * fq + e) * 72 + 16 * wave + fr];
#pragma unroll
      for (int nt = 0; nt < 8; ++nt) {
        bf16x8 bg;
#pragma unroll
        for (int e = 0; e < 8; ++e) bg[e] = (short)Bm[(8 * fq + e) * 136 + 16 * nt + fr];
#pragma unroll
        for (int j = 0; j < 4; ++j) Sacc[nt][j] *= cd;
        Sacc[nt] = MFMA16(a, bg, Sacc[nt]);
      }
    }
    __syncthreads();
#pragma unroll
    for (int nt = 0; nt < 8; ++nt)
#pragma unroll
      for (int j = 0; j < 4; ++j) Sb[(16 * wave + 4 * fq + j) * 136 + 16 * nt + fr] = f2bf(Sacc[nt][j]);
    if (!dry && zt < nv) *(u32x4*)(U + uidx(row0 + t0 + zt, cZB + h * 64 + zc)) = *(const u32x4*)&Zs[zt * 72 + zc];
    __syncthreads();
  }
  if (!dry) {
    float* so = p.out + (samp ? oSSS + (((size_t)layer * NSB + b) * HB + h) * 64 * DS : oPSS + (((size_t)layer * NB + b) * HB + h) * 64 * DS);
#pragma unroll
    for (int nt = 0; nt < 8; ++nt)
#pragma unroll
      for (int j = 0; j < 4; ++j) so[(16 * wave + 4 * fq + j) * DS + 16 * nt + fr] = Sacc[nt][j];
  }
}

DI void sb_item(int wv, const Params& p, int layer, int b, int h, int qb, bool samp, char* smc, bool dry) {
  const int otid = opaque_tid(wv);
  const int tid = otid, lane = tid & 63, wave = tid >> 6, fr = lane & 15, fq = lane >> 4;
  u16* U = (u16*)(p.ws + wsU);
  u16* Qs = (u16*)smc;
  u16* Ks = Qs + 64 * 72;
  u16* VT = Ks + 64 * 72;
  u16* Ps = VT + 64 * 72 + 128;
  float* flag = (float*)(Ps + 64 * 72);
  const int nq = samp ? SSEQ : 64;
  const int qpos0 = samp ? PAST : 64 * qb;
  const long rowq0 = samp ? (long)MP + b * SSEQ : (long)b * SEQ + 64 * qb;
  const int ktlast = samp ? 16 : qb;
  const float* kbase = samp ? p.in[6] + (((size_t)layer * NSB + b) * HC + h) * PAST * 64
                            : p.out + oPK + (((size_t)layer * NB + b) * HC + h) * SEQ * 64;
  const float* vbase = samp ? p.in[7] + (((size_t)layer * NSB + b) * HC + h) * PAST * 64
                            : p.out + oPV + (((size_t)layer * NB + b) * HC + h) * SEQ * 64;
  const float* knew = p.out + oSK + (((size_t)layer * NSB + b) * HC + h) * SSEQ * 64;
  const float* vnew = p.out + oSV + (((size_t)layer * NSB + b) * HC + h) * SSEQ * 64;
  __syncthreads();
#pragma unroll
  for (int i = 0; i < 2; ++i) {
    const int id = tid + 256 * i, r = id >> 3, c8 = id & 7;
    u32x4 v = {0u, 0u, 0u, 0u};
    if (r < nq) v = *(const u32x4*)(U + uidx(rowq0 + r, cQ + h * 64 + c8 * 8));
    *(u32x4*)(Qs + r * 72 + c8 * 8) = v;
  }
  float carry[4] = {0.f, 0.f, 0.f, 0.f};
  f32x4 O[4];
#pragma unroll
  for (int i = 0; i < 4; ++i) O[i] = f32x4{0.f, 0.f, 0.f, 0.f};
  int itn = 0;
  float4 kr[4], vr[4];
  auto fetch = [&](int kt) {
#pragma unroll
    for (int i = 0; i < 4; ++i) {
      const int id = tid + 256 * i, r = id >> 4, c4 = id & 15;
      const int key = 64 * (kt < 0 ? 0 : kt) + r;
      const float* kp;
      const float* vp;
      if (!samp || key < PAST) { kp = kbase + (size_t)key * 64; vp = vbase + (size_t)key * 64; }
      else { const int kn = min(key - PAST, SSEQ - 1); kp = knew + (size_t)kn * 64; vp = vnew + (size_t)kn * 64; }
      kr[i] = *(const float4*)(kp + c4 * 4);
      vr[i] = *(const float4*)(vp + c4 * 4);
    }
  };
  fetch(ktlast);
  for (int kt = ktlast; kt >= 0; --kt, ++itn) {
    __syncthreads();
    if (kt != ktlast) {
      const float* fl = flag + ((itn - 1) & 1) * 4;
      float m = fmaxf(fmaxf(fl[0], fl[1]), fmaxf(fl[2], fl[3]));
      if (m < -104.f) break;
    }
#pragma unroll
    for (int i = 0; i < 4; ++i) {
      const int id = tid + 256 * i, r = id >> 4, c4 = id & 15;
      const int key = 64 * kt + r;
      float4 kv = kr[i], vv = vr[i];
      if (samp && key >= PAST + SSEQ) { kv = float4{0.f, 0.f, 0.f, 0.f}; vv = kv; }
      u32x2 kw;
      kw[0] = pack2(kv.x, kv.y);
      kw[1] = pack2(kv.z, kv.w);
      *(u32x2*)(Ks + r * 72 + c4 * 4) = kw;
      VT[(c4 * 4 + 0) * 72 + c4 * 8 + r] = f2bf(vv.x);
      VT[(c4 * 4 + 1) * 72 + c4 * 8 + r] = f2bf(vv.y);
      VT[(c4 * 4 + 2) * 72 + c4 * 8 + r] = f2bf(vv.z);
      VT[(c4 * 4 + 3) * 72 + c4 * 8 + r] = f2bf(vv.w);
    }
    fetch(kt - 1);
    __syncthreads();
    f32x4 z[4];
#pragma unroll
    for (int n = 0; n < 4; ++n) z[n] = f32x4{0.f, 0.f, 0.f, 0.f};
#pragma unroll
    for (int ks = 0; ks < 2; ++ks) {
      bf16x8 a = ldfrag(Qs, 72, 16 * wave + fr, 32 * ks + 8 * fq);
#pragma unroll
      for (int n = 0; n < 4; ++n) z[n] = MFMA16(a, ldfrag(Ks, 72, 16 * n + fr, 32 * ks + 8 * fq), z[n]);
    }
    float cmax = -1e30f;
#pragma unroll
    for (int j = 0; j < 4; ++j) {
      const int ql = 16 * wave + 4 * fq + j;
      const int qpos = qpos0 + ql;
      float lk[4], sfx[4], tot[4];
#pragma unroll
      for (int n = 0; n < 4; ++n) {
        const int kpos = 64 * kt + 16 * n + fr;
        lk[n] = (kpos < qpos) ? -softplusf(z[n][j]) : 0.f;
        float v = lk[n];
        v += dppf<0x101>(v);
        v += dppf<0x102>(v);
        v += dppf<0x104>(v);
        v += dppf<0x108>(v);
        sfx[n] = v;
        tot[n] = swzf<0x0010>(v);
      }
      float later = carry[j];
#pragma unroll
      for (int n = 3; n >= 0; --n) {
        const int kpos = 64 * kt + 16 * n + fr;
        float tail = (sfx[n] - lk[n]) + later;
        float att = (kpos < qpos) ? __expf(z[n][j] + lk[n] + tail) : 0.f;
        Ps[ql * 72 + 16 * n + fr] = f2bf(att);
        later += tot[n];
      }
      carry[j] = later;
      if (ql < nq) cmax = fmaxf(cmax, later);
    }
    cmax = fmaxf(cmax, dppf<0x128>(cmax)); cmax = fmaxf(cmax, dppf<0x124>(cmax)); cmax = fmaxf(cmax, dppf<0x122>(cmax)); cmax = fmaxf(cmax, dppf<0x121>(cmax));
    cmax = fmaxf(cmax, sx16(cmax)); cmax = fmaxf(cmax, bperm(cmax, lane ^ 32));
    if (lane == 0) flag[(itn & 1) * 4 + wave] = cmax;
#pragma unroll
    for (int ks = 0; ks < 2; ++ks) {
      bf16x8 a = ldfrag(Ps, 72, 16 * wave + fr, 32 * ks + 8 * fq);
#pragma unroll
      for (int dn = 0; dn < 4; ++dn) O[dn] = MFMA16(a, ldfrag(VT + (((16 * dn + fr) >> 2) << 3), 72, 16 * dn + fr, 32 * ks + 8 * fq), O[dn]);
    }
  }
#pragma unroll
  for (int j = 0; j < 4; ++j) {
    const int ql = 16 * wave + 4 * fq + j;
    if (!dry && ql < nq) {
#pragma unroll
      for (int dn = 0; dn < 4; ++dn) {
        u16* gp = U + uidx(rowq0 + ql, cGC + h * 64 + 16 * dn + fr);
        *gp = f2bf(O[dn][j] * silu(bf2f(*gp)));
      }
    }
  }
}

constexpr int IT_RP = NB * HA, IT_MP = NB * HB, IT_RS = NSB * HA, IT_MS = NSB * HB, IT_SS = NSB * HC, IT_SP = NB * HC * (SEQ / 64);
constexpr int IT_CV = NB * 20 + NSB * 20;
constexpr int NITEMS = IT_RP + IT_CV + IT_MP + IT_RS + IT_MS + IT_SS + IT_SP;
DI void phase_mixers(int wv, const Params& p, int layer, char* smc, int dryType) {
  const int otid = opaque_tid(wv);
  __shared__ int s_item;
  int* cnt = (int*)(p.ws + wsCNT) + layer + (dryType >= 0 ? 2 : 0);
  const bool dry = dryType >= 0;
  for (;;) {
    __syncthreads();
    if (otid == 0) s_item = atomicAdd(cnt, 1);
    __syncthreads();
    int it = s_item;
    if (it >= NITEMS) break;
    int type, b = 0, h = 0, qb = 0, cvit = 0; bool samp = false;
    if (it < IT_RP) { type = 0; b = it / HA; h = it % HA; }
    else if ((it -= IT_RP) < IT_CV) { type = 3; cvit = it; }
    else if ((it -= IT_CV) < IT_MP) { type = 1; b = it / HB; h = it % HB; }
    else if ((it -= IT_MP) < IT_RS) { type = 0; samp = true; b = it / HA; h = it % HA; }
    else if ((it -= IT_RS) < IT_MS) { type = 1; samp = true; b = it / HB; h = it % HB; }
    else if ((it -= IT_MS) < IT_SS) { type = 2; samp = true; b = it / HC; h = it % HC; }
    else { it -= IT_SS; type = 2; qb = it % (SEQ / 64); int bh = it / (SEQ / 64); b = bh / HC; h = bh % HC; }
#ifndef ITEMS
#define ITEMS 7
#endif
    if (dry && type != dryType) continue;
    if (type == 0) { if (ITEMS & 1) { __builtin_amdgcn_s_setprio(3); rwkv_item(wv, p, layer, b, h, samp, smc, dry); __builtin_amdgcn_s_setprio(0); } }
    else if (type == 1) { if (ITEMS & 2) mamba_item(wv, p, layer, b, h, samp, smc, dry); }
    else if (type == 3) conv_item(wv, p, layer, cvit);
    else { if (ITEMS & 4) sb_item(wv, p, layer, b, h, qb, samp, smc, dry); }
  }
}

DI void phase_mnorm(int wv, const Params& p) {
  const int otid = opaque_tid(wv);
  u16* U = (u16*)(p.ws + wsU);
  const float* SSQ = (const float*)(p.ws + wsSSQ);
  const long total = (long)MT * 96;
  for (long i = (long)blockIdx.x * 256 + otid; i < total; i += (long)gridDim.x * 256) {
    long row = i / 96;
    int c8 = (int)(i % 96), g = c8 / 48;
    float rs = rsqrtf(SSQ[row * 2 + g] * (1.f / 384.f) + 1e-5f);
    u32x4* ptr = (u32x4*)(U + uidx(row, cZB + c8 * 8));
    u32x4 v = *ptr;
#pragma unroll
    for (int e = 0; e < 4; ++e) {
      float lo = __uint_as_float(v[e] << 16) * rs, hi = __uint_as_float(v[e] & 0xffff0000u) * rs;
      v[e] = pack2(lo, hi);
    }
    *ptr = v;
  }
}

__global__ void __launch_bounds__(256, 2) fwd_kernel(Params p, int ph_lo, int ph_hi, int coop) {
  __shared__ __attribute__((aligned(16))) char smc[65536 - 64];
  const int wv = __builtin_amdgcn_readfirstlane(threadIdx.x >> 6);
#ifndef ONLY
#define ONLY 255
#endif
#define RUN(PH, BIT, CALL) if (ph_lo <= (PH) && (PH) <= ph_hi) { if (ONLY & (BIT)) { CALL; } if ((PH) < ph_hi && coop) cg::this_grid().sync(); }
  RUN(0, 1, phase_wprep(wv, p, smc))
#pragma unroll
  for (int layer = 0; layer < 2; ++layer) {
    const int pb = 1 + 4 * layer;
    RUN(pb + 0, 2, phase_norm(wv, p, layer))
    RUN(pb + 1, 4, phase_inproj(wv, p, layer, smc))
#ifdef DRYTYPE
    if (ph_lo <= pb + 2 && pb + 2 <= ph_hi) {
#pragma unroll 1
      for (int pass = 0; pass < 2; ++pass) {
        phase_mixers(wv, p, layer, smc, pass == 0 ? DRYTYPE : -1);
        if (coop) cg::this_grid().sync();
      }
    }
#else
    RUN(pb + 2, 8, phase_mixers(wv, p, layer, smc, -1))
#endif
    RUN(pb + 3, 32, phase_outproj(wv, p, layer, smc))
  }
}

extern "C" void kernel_launch(void* const* d_in, const int* in_sizes, int n_in, void* d_out, int out_size, void* d_ws,
                              size_t ws_size, hipStream_t stream) {
  static int grid_blocks = 0;
  if (!grid_blocks) {
    int dev = 0, cus = 0, per_cu = 0;
    hipGetDevice(&dev);
    hipDeviceGetAttribute(&cus, hipDeviceAttributeMultiprocessorCount, dev);
    hipOccupancyMaxActiveBlocksPerMultiprocessor(&per_cu, fwd_kernel, 256, 0);
    if (per_cu < 1) per_cu = 1;
    if (per_cu > 2) per_cu = 2;
    grid_blocks = cus * per_cu;
  }
  Params p{};
  for (int i = 0; i < 29; ++i) p.in[i] = (const float*)d_in[i];
  p.out = (float*)d_out;
  p.ws = (char*)d_ws;
#ifdef MULTI_LAUNCH
  for (int ph = 0; ph <= 8; ++ph) {
    hipLaunchKernelGGL(fwd_kernel, dim3(grid_blocks), dim3(256), 0, stream, p, ph, ph, 0);
  }
#else
  int lo = 0, hi = 8, coop = 1;
  void* args[] = {&p, &lo, &hi, &coop};
  hipError_t e = hipLaunchCooperativeKernel((void*)fwd_kernel, dim3(grid_blocks), dim3(256), args, 0, stream);
  if (e != hipSuccess) fprintf(stderr, "cooperative launch failed: %s (grid %d)\n", hipGetErrorString(e), grid_blocks);
#endif
}
```
